# Optimizing an MI355X kernel written in HIP

```python
import math
import jax
import jax.numpy as jnp
from jax import lax
import numpy as np

D_MODEL = 2048
BATCH = 4
SEQ = 2048
DEPTH = 1

ATTN_HEAD_DIM = 64
D_ATTN = D_MODEL // 2
N_ATTN_HEADS = D_ATTN // ATTN_HEAD_DIM
ROT_DIM = ATTN_HEAD_DIM // 4
ROPE_THETA = 500000.0
DILATED_PATTERNS = ((128, 1), (512, 4), (2048, 16))
ATTN_BLOCK = 128
SSM_HEAD_DIM = 64
D_SSM = D_MODEL // 2
N_SSM_HEADS = D_SSM // SSM_HEAD_DIM
SSM_GROUPS = 4
SSM_STATE = 128
CONV_WIDTH = 4
SSD_CHUNK = 128
D_CONV = D_SSM + 2 * SSM_GROUPS * SSM_STATE
DT_MIN = 1e-3
DT_MAX = 1e-1
D_MIX = D_ATTN + D_SSM
D_IN = 3 * D_ATTN + D_SSM + D_CONV + N_SSM_HEADS
N_MEM = 256
N_CROSS_HEADS = 4
CROSS_HEAD_DIM = 128
D_CROSS = N_CROSS_HEADS * CROSS_HEAD_DIM
D_FF = 4 * D_MODEL
EPS = 1e-6

kernel_name = "hymba_ssd_dilated_attn_memxattn_sqrelu"


def rms_norm(x, g):
    xf = x.astype(jnp.float32)
    y = xf * lax.rsqrt(jnp.mean(xf * xf, axis=-1, keepdims=True) + EPS)
    return (y * g.astype(jnp.float32)).astype(x.dtype)


def partial_rope(x, positions):
    half = ROT_DIM // 2
    inv_freq = ROPE_THETA ** (-2.0 * jnp.arange(half, dtype=jnp.float32) / ROT_DIM)
    ang = positions.astype(jnp.float32)[..., None] * inv_freq
    cos = jnp.cos(ang)[:, :, None, :]
    sin = jnp.sin(ang)[:, :, None, :]
    xf = x.astype(jnp.float32)
    x1 = xf[..., :half]
    x2 = xf[..., half:ROT_DIM]
    out = jnp.concatenate([x1 * cos - x2 * sin, x2 * cos + x1 * sin, xf[..., ROT_DIM:]], axis=-1)
    return out.astype(x.dtype)


def dilated_window_branch(q, k, v, window, dilation):
    bsz, s_len, n_h, hd = q.shape
    steps = window // dilation
    span = dilation * ATTN_BLOCK
    s_pad = -(-s_len // span) * span
    nb = s_pad // span

    def to_blocks(t):
        t = jnp.pad(t, ((0, 0), (0, s_pad - s_len), (0, 0), (0, 0)))
        return t.reshape(bsz, nb, ATTN_BLOCK, dilation, n_h, hd)

    qb, kb, vb = to_blocks(q), to_blocks(k), to_blocks(v)

    def band(t):
        prev = jnp.concatenate([jnp.zeros_like(t[:, :1]), t[:, :-1]], axis=1)
        return jnp.concatenate([prev, t], axis=2)

    kband, vband = band(kb), band(vb)
    s = jnp.einsum('bnqrhd,bnkrhd->bnrhqk', qb, kband)
    qi = jnp.arange(ATTN_BLOCK)[:, None]
    kj = jnp.arange(2 * ATTN_BLOCK)[None, :]
    dist = qi + ATTN_BLOCK - kj
    in_window = (dist >= 0) & (dist <= steps)
    has_prev = (jnp.arange(nb)[:, None, None] > 0) | (kj[None] >= ATTN_BLOCK)
    mask = in_window[None] & has_prev
    s = jnp.where(mask[None, :, None, None], s, -jnp.inf)
    m = jnp.max(s, axis=-1, keepdims=True)
    p = jnp.exp(s - m)
    denom = jnp.sum(p, axis=-1)
    lse = m[..., 0] + jnp.log(denom)
    o = jnp.einsum('bnrhqk,bnkrhd->bnqrhd', p, vband)
    o = o / jnp.transpose(denom, (0, 1, 4, 2, 3))[..., None]
    o = o.reshape(bsz, s_pad, n_h, hd)[:, :s_len]
    lse = jnp.transpose(lse, (0, 1, 4, 2, 3)).reshape(bsz, s_pad, n_h)[:, :s_len]
    return o, lse


def dilated_attention(q, k, v, positions, g_q, g_k):
    q = partial_rope(rms_norm(q, g_q), positions).astype(jnp.float32) * (ATTN_HEAD_DIM ** -0.5)
    k = partial_rope(rms_norm(k, g_k), positions).astype(jnp.float32)
    v = v.astype(jnp.float32)
    outs, lses = [], []
    for window, dilation in DILATED_PATTERNS:
        o, l = dilated_window_branch(q, k, v, window, dilation)
        outs.append(o)
        lses.append(l)
    wts = jax.nn.softmax(jnp.stack(lses, axis=0), axis=0)
    return jnp.einsum('gbsh,gbshd->bshd', wts, jnp.stack(outs, axis=0))


def ssd_chunked(x, dt, a, b_mat, c_mat):
    bsz, l_len, n_h, p_dim = x.shape
    g, n = b_mat.shape[2], b_mat.shape[3]
    hg = n_h // g
    nc = l_len // SSD_CHUNK
    q = SSD_CHUNK
    xc = x.reshape(bsz, nc, q, g, hg, p_dim)
    dtc = dt.reshape(bsz, nc, q, g, hg)
    bc = b_mat.reshape(bsz, nc, q, g, n)
    cc = c_mat.reshape(bsz, nc, q, g, n)
    a_cs = jnp.cumsum(dtc * a.reshape(g, hg), axis=2)
    seg = a_cs[:, :, :, None] - a_cs[:, :, None, :]
    causal = jnp.tril(jnp.ones((q, q), dtype=bool))[:, :, None, None]
    l_mat = jnp.exp(jnp.where(causal, seg, -jnp.inf))
    cb = jnp.einsum('bclgn,bcsgn->bclsg', cc, bc)
    w = cb[..., None] * l_mat * dtc[:, :, None]
    y_diag = jnp.einsum('bclsgh,bcsghp->bclghp', w, xc)
    decay_states = jnp.exp(a_cs[:, :, -1:] - a_cs)
    states = jnp.einsum('bcsgn,bcsgh,bcsghp->bcghpn', bc, decay_states * dtc, xc)
    chunk_decay = jnp.exp(a_cs[:, :, -1])

    def step(h, inp):
        s_c, a_c = inp
        return h * a_c[..., None, None] + s_c, h

    h0 = jnp.zeros((bsz, g, hg, p_dim, n), jnp.float32)
    _, prev = lax.scan(step, h0, (jnp.moveaxis(states, 1, 0), jnp.moveaxis(chunk_decay, 1, 0)))
    prev = jnp.moveaxis(prev, 0, 1)
    y_off = jnp.einsum('bclgn,bcghpn->bclghp', cc, prev) * jnp.exp(a_cs)[..., None]
    return (y_diag + y_off).reshape(bsz, l_len, n_h, p_dim)


def ssd_mixer(z, xbc, dt_raw, conv_w, conv_b, dt_bias, a_log, d_skip, g_out):
    bsz, l_len, _ = xbc.shape
    xbc = lax.conv_general_dilated(
        xbc, conv_w.astype(xbc.dtype)[:, None, :], window_strides=(1,),
        padding=[(CONV_WIDTH - 1, 0)], dimension_numbers=('NWC', 'WIO', 'NWC'),
        feature_group_count=D_CONV) + conv_b.astype(xbc.dtype)
    xbc = jax.nn.silu(xbc)
    xs = xbc[..., :D_SSM].astype(jnp.float32).reshape(bsz, l_len, N_SSM_HEADS, SSM_HEAD_DIM)
    b_mat = xbc[..., D_SSM:D_SSM + SSM_GROUPS * SSM_STATE].astype(jnp.float32).reshape(bsz, l_len, SSM_GROUPS, SSM_STATE)
    c_mat = xbc[..., D_SSM + SSM_GROUPS * SSM_STATE:].astype(jnp.float32).reshape(bsz, l_len, SSM_GROUPS, SSM_STATE)
    dt = jax.nn.softplus(dt_raw.astype(jnp.float32) + dt_bias.astype(jnp.float32))
    a = -jnp.exp(a_log.astype(jnp.float32))
    y = ssd_chunked(xs, dt, a, b_mat, c_mat) + d_skip.astype(jnp.float32)[:, None] * xs
    y = y.reshape(bsz, l_len, D_SSM) * jax.nn.silu(z.astype(jnp.float32))
    y = rms_norm(y.reshape(bsz, l_len, SSM_GROUPS, D_SSM // SSM_GROUPS),
                 g_out.reshape(SSM_GROUPS, D_SSM // SSM_GROUPS))
    return y.reshape(bsz, l_len, D_SSM).astype(z.dtype)


def cross_attention(h, mem_h, w_q, w_kv, w_o, g_q, g_k):
    bsz, s_len, _ = h.shape
    q = (h @ w_q).reshape(bsz, s_len, N_CROSS_HEADS, CROSS_HEAD_DIM)
    kv = (mem_h @ w_kv).reshape(bsz, -1, 2, N_CROSS_HEADS, CROSS_HEAD_DIM)
    k, v = kv[:, :, 0], kv[:, :, 1]
    q = rms_norm(q, g_q).astype(jnp.float32) * (CROSS_HEAD_DIM ** -0.5)
    k = rms_norm(k, g_k).astype(jnp.float32)
    p = jax.nn.softmax(jnp.einsum('bshd,bmhd->bhsm', q, k), axis=-1)
    o = jnp.einsum('bhsm,bmhd->bshd', p, v.astype(jnp.float32)).astype(h.dtype)
    return o.reshape(bsz, s_len, D_CROSS) @ w_o


def setup_inputs(seed: int = 0) -> dict:
    key = jax.random.key(seed)
    ks = jax.random.split(key, 26)
    f32 = jnp.float32

    def nrm(k, shape, scale):
        return jax.random.normal(k, shape, f32) * scale

    def gain(k, shape):
        return 1.0 + 0.02 * jax.random.normal(k, shape, f32)

    dt0 = jnp.exp(jax.random.uniform(ks[9], (DEPTH, N_SSM_HEADS), f32, math.log(DT_MIN), math.log(DT_MAX)))
    return {
        "x": nrm(ks[0], (BATCH, SEQ, D_MODEL), 1.0),
        "mem": nrm(ks[1], (BATCH, N_MEM, D_MODEL), 1.0),
        "positions": jnp.broadcast_to(jnp.arange(SEQ, dtype=jnp.int32), (BATCH, SEQ)),
        "g_mix": gain(ks[2], (DEPTH, D_MODEL)),
        "w_in": nrm(ks[3], (DEPTH, D_MODEL, D_IN), D_MODEL ** -0.5),
        "g_q": gain(ks[4], (DEPTH, ATTN_HEAD_DIM)),
        "g_k": gain(ks[5], (DEPTH, ATTN_HEAD_DIM)),
        "g_attn_out": gain(ks[6], (DEPTH, D_ATTN)),
        "conv_w": nrm(ks[7], (DEPTH, CONV_WIDTH, D_CONV), CONV_WIDTH ** -0.5),
        "conv_b": nrm(ks[8], (DEPTH, D_CONV), 0.02),
        "dt_bias": dt0 + jnp.log(-jnp.expm1(-dt0)),
        "a_log": jnp.log(jax.random.uniform(ks[10], (DEPTH, N_SSM_HEADS), f32, 1.0, 16.0)),
        "d_skip": 1.0 + 0.1 * jax.random.normal(ks[11], (DEPTH, N_SSM_HEADS), f32),
        "g_ssm_out": gain(ks[12], (DEPTH, D_SSM)),
        "w_out": nrm(ks[13], (DEPTH, D_MIX, D_MODEL), D_MIX ** -0.5),
        "g_cross": gain(ks[14], (DEPTH, D_MODEL)),
        "g_mem": gain(ks[15], (DEPTH, D_MODEL)),
        "w_cq": nrm(ks[16], (DEPTH, D_MODEL, D_CROSS), D_MODEL ** -0.5),
        "w_ckv": nrm(ks[17], (DEPTH, D_MODEL, 2 * D_CROSS), D_MODEL ** -0.5),
        "g_cq": gain(ks[18], (DEPTH, CROSS_HEAD_DIM)),
        "g_ck": gain(ks[19], (DEPTH, CROSS_HEAD_DIM)),
        "w_co": nrm(ks[20], (DEPTH, D_CROSS, D_MODEL), D_CROSS ** -0.5),
        "g_mlp": gain(ks[21], (DEPTH, D_MODEL)),
        "w_up": nrm(ks[22], (DEPTH, D_MODEL, D_FF), D_MODEL ** -0.5),
        "w_down": nrm(ks[23], (DEPTH, D_FF, D_MODEL), D_FF ** -0.5),
    }


def reference(x, mem, positions, g_mix, w_in, g_q, g_k, g_attn_out, conv_w, conv_b, dt_bias,
              a_log, d_skip, g_ssm_out, w_out, g_cross, g_mem, w_cq, w_ckv, g_cq, g_ck, w_co,
              g_mlp, w_up, w_down):
    bsz, s_len, _ = x.shape
    splits = np.cumsum([D_ATTN, D_ATTN, D_ATTN, D_SSM, D_CONV]).tolist()
    for i in range(DEPTH):
        h = rms_norm(x, g_mix[i])
        q, k, v, z, xbc, dt_raw = jnp.split(h @ w_in[i], splits, axis=-1)
        shp = (bsz, s_len, N_ATTN_HEADS, ATTN_HEAD_DIM)
        attn = dilated_attention(q.reshape(shp), k.reshape(shp), v.reshape(shp), positions, g_q[i], g_k[i])
        attn = rms_norm(attn.reshape(bsz, s_len, D_ATTN), g_attn_out[i]).astype(x.dtype)
        ssm = ssd_mixer(z, xbc, dt_raw, conv_w[i], conv_b[i], dt_bias[i], a_log[i], d_skip[i], g_ssm_out[i])
        x = x + jnp.concatenate([attn, ssm], axis=-1) @ w_out[i]
        x = x + cross_attention(rms_norm(x, g_cross[i]), rms_norm(mem, g_mem[i]),
                                w_cq[i], w_ckv[i], w_co[i], g_cq[i], g_ck[i])
        hm = rms_norm(x, g_mlp[i])
        x = x + jnp.square(jax.nn.relu(hm @ w_up[i])) @ w_down[i]
    return x
```

```cpp
#include <hip/hip_runtime.h>
#include <hip/hip_cooperative_groups.h>
#include <cstdio>
#include <cstdint>
namespace cg = cooperative_groups;

#ifndef PROBE_DUP
#define PROBE_DUP -1
#endif
#ifndef MK_COOP
#define MK_COOP 1
#endif

#define LAS __attribute__((address_space(3)))
typedef unsigned short bf16_t;
typedef short bf16x8 __attribute__((ext_vector_type(8)));
typedef short s16x4 __attribute__((ext_vector_type(4)));
typedef float f32x2 __attribute__((ext_vector_type(2)));
typedef float f32x4 __attribute__((ext_vector_type(4)));
typedef float f32x16 __attribute__((ext_vector_type(16)));
typedef unsigned u32x4 __attribute__((ext_vector_type(4)));
typedef unsigned u32x2 __attribute__((ext_vector_type(2)));

constexpr int DM = 2048, NB = 4, SEQ = 2048, MTOK = NB * SEQ;
constexpr int DIN = 6160, NPROJ = 6144;
constexpr int NMEM = 256, MMEM = NB * NMEM, DCROSS = 512, DFF = 8192;
constexpr float EPS = 1e-6f;
constexpr int PC_Q = 0, PC_Z = 1024, PC_K = 2048, PC_V = 3072, PC_X = 4096;

constexpr size_t MiB = 1u << 20;
constexpr size_t WS_WOUT = 0, WS_WCQ = 8 * MiB, WS_WCKV = 10 * MiB, WS_WCO = 14 * MiB, WS_WUP = 16 * MiB, WS_WDOWN = 48 * MiB;
constexpr size_t WS_SMALL = 80 * MiB;
constexpr size_t WS_DT = WS_SMALL, WS_RSTD0 = WS_SMALL + 512 * 1024, WS_RSTDM = WS_RSTD0 + 32 * 1024, WS_SUMSQ1 = WS_RSTDM + 4096, WS_SUMSQ2 = WS_SUMSQ1 + 32 * 1024,
                 WS_ATOT = WS_SUMSQ2 + 32 * 1024, WS_LSE = WS_SMALL + 1 * MiB, WS_MEMB = WS_SMALL + 3 * MiB, WS_KC = WS_SMALL + 7 * MiB, WS_VCT = WS_SMALL + 8 * MiB;
constexpr size_t WS_BAR = WS_SMALL + 9 * MiB, BAR_BYTES = 16384;
constexpr size_t WS_WIN = 92 * MiB, WS_XB = 116 * MiB, WS_PROJ = 148 * MiB, WS_STATES = 244 * MiB;
constexpr size_t WS_OBR = 92 * MiB, WS_X1B = 92 * MiB, WS_KVPART = 140 * MiB, WS_QPART = 148 * MiB, WS_CO = 212 * MiB, WS_X2B = 220 * MiB, WS_HID = 92 * MiB;
constexpr size_t WS_END = 276 * MiB;

constexpr int LDS_BYTES = 155648;
constexpr int NPHASE = 11;

__device__ __forceinline__ unsigned f2bf(float f) { unsigned u = __float_as_uint(f); return (u + 0x7fffu + ((u >> 16) & 1u)) >> 16; }
__device__ __forceinline__ unsigned pk2(float lo, float hi) { unsigned r; asm volatile("v_cvt_pk_bf16_f32 %0, %1, %2" : "=v"(r) : "v"(lo), "v"(hi)); return r; }
__device__ __forceinline__ float bflo(unsigned w) { return __uint_as_float(w << 16); }
__device__ __forceinline__ float bfhi(unsigned w) { return __uint_as_float(w & 0xffff0000u); }
__device__ __forceinline__ float wave_sum(float v) {
#pragma unroll
    for (int o = 1; o < 64; o <<= 1) v += __shfl_xor(v, o);
    return v;
}
__device__ __forceinline__ bf16x8 pack8(float a0, float a1, float a2, float a3, float a4, float a5, float a6, float a7) {
    u32x4 w; w.x = pk2(a0, a1); w.y = pk2(a2, a3); w.z = pk2(a4, a5); w.w = pk2(a6, a7);
    return __builtin_bit_cast(bf16x8, w);
}
#define MFMA32(a, b, c) __builtin_amdgcn_mfma_f32_32x32x16_bf16((a), (b), (c), 0, 0, 0)
__device__ __forceinline__ f32x16 zero16() { f32x16 z;
#pragma unroll
    for (int i = 0; i < 16; ++i) z[i] = 0.f; return z; }

namespace pg8 {
constexpr int BM = 256, BK = 64, HALF = 128, HTB = HALF * BK * 2, NXCD = 8, WGM = 4;
__device__ __forceinline__ int lds_byte(int r, int c) { const int st = (r >> 4) * 2 + (c >> 5), rr = r & 15, cc = c & 31, ob = rr * 64 + cc * 2; return st * 1024 + (ob ^ (((ob >> 9) & 1) << 5)); }
__device__ __forceinline__ void stage_rc(int b, int& R, int& C) { const int st = b / 1024, sb = b % 1024, swz = sb ^ (((sb >> 9) & 1) << 5); R = (st >> 1) * 16 + swz / 64; C = (st & 1) * 32 + (swz % 64) / 2; }
__device__ __forceinline__ int perm32(int rho) { const int n = rho >> 4, i = rho & 15; return 8 * (i >> 2) + 4 * n + (i & 3); }

struct Unit { int pm, pn, ks; };
struct Gemm { const bf16_t* A; const bf16_t* Bt; int lda, ldb, nM, nN, nKS, Klen, G, c; };

__device__ __forceinline__ bool next_unit(const Gemm& g, int i, Unit& u) {
    const int nwg = g.nM * g.nN; const long L = (long)i * g.G + g.c; if (L >= (long)nwg * g.nKS) return false;
    u.ks = (int)(L / nwg); int wgid = (int)(L % nwg);
    { const int q = nwg / NXCD, r = nwg % NXCD, xcd = wgid % NXCD, off = wgid / NXCD; wgid = (xcd < r ? xcd * (q + 1) : r * (q + 1) + (xcd - r) * q) + off; }
    const int nig = WGM * g.nN, gid = wgid / nig, fm = gid * WGM, gsz = (g.nM - fm) < WGM ? (g.nM - fm) : WGM;
    u.pm = fm + ((wgid % nig) % gsz); u.pn = (wgid % nig) / gsz; return true;
}

template <class Epi>
__device__ __forceinline__ void gemm_phase(LAS unsigned char* lds, const Gemm g, const Epi& E) {
    const int tid = threadIdx.x, wid = __builtin_amdgcn_readfirstlane(tid >> 6), lane = tid & 63, wr = wid >> 2, wc = wid & 3, fr = lane & 15, fq = lane >> 4;
    const int nt = g.Klen / BK;
    unsigned voffA[2], voffB[2];
#pragma unroll
    for (int i = 0; i < 2; ++i) { int R, C; stage_rc(tid * 16 + i * 8192, R, C); const int Rb = Epi::PERM ? ((R & ~31) + perm32(R & 31)) : R;
        voffA[i] = (unsigned)(R * g.lda + C) * 2u; voffB[i] = (unsigned)(Rb * g.ldb + C) * 2u; }
    const size_t kstep = (size_t)(BK * 2);
    const size_t hstepA = (size_t)HALF * g.lda * 2, hstepB = (size_t)HALF * g.ldb * 2;
    const size_t tstepA = 2 * hstepA, tstepB = 2 * hstepB;
    const size_t ksoff = (size_t)g.Klen * 2;
    const unsigned ldsw = (unsigned)wid * 1024u;
    const int aoff = lds_byte(wr * 64 + fr, fq * 8), boff = lds_byte(wc * 32 + fr, fq * 8);
#define PG8_SA(b, h) (((b) * 2 + (h)) * HTB)
#define PG8_SB(b, h) ((4 + (b) * 2 + (h)) * HTB)
#define PG8_STAGE(bufoff, gbase, voff) do { _Pragma("unroll") for (int _i = 0; _i < 2; ++_i) \
        __builtin_amdgcn_global_load_lds((const unsigned*)((const char*)(gbase) + (voff)[_i]), (LAS unsigned*)(lds + (bufoff) + ldsw + _i * 8192), 16, 0, 0); } while (0)
#define PG8_LDA(dst, b, h) do { _Pragma("unroll") for (int m = 0; m < 4; ++m) _Pragma("unroll") for (int k = 0; k < 2; ++k) dst[m][k] = *(const LAS bf16x8*)(lds + PG8_SA(b, h) + aoff + m * 2048 + k * 1024); } while (0)
#define PG8_LDB(dst, b, h) do { _Pragma("unroll") for (int n = 0; n < 2; ++n) _Pragma("unroll") for (int k = 0; k < 2; ++k) dst[n][k] = *(const LAS bf16x8*)(lds + PG8_SB(b, h) + boff + n * 2048 + k * 1024); } while (0)
#define PG8_MMA(ai, bj, At, Bt) do { __builtin_amdgcn_s_setprio(1); _Pragma("unroll") for (int m = 0; m < 4; ++m) _Pragma("unroll") for (int n = 0; n < 2; ++n) _Pragma("unroll") for (int k = 0; k < 2; ++k) \
        acc[ai][bj][m][n] = __builtin_amdgcn_mfma_f32_16x16x32_bf16(Bt[n][k], At[m][k], acc[ai][bj][m][n], 0, 0, 0); __builtin_amdgcn_s_setprio(0); } while (0)
#define PG8_WAIT_V(n) asm volatile("s_waitcnt vmcnt(" #n ")" ::: "memory")
#define PG8_WAIT_L(n) asm volatile("s_waitcnt lgkmcnt(" #n ")" ::: "memory")
#define PG8_BAR __builtin_amdgcn_s_barrier()
#define PG8_SCHED __builtin_amdgcn_sched_barrier(0)
    Unit cur, nxt; int ui = 0;
    if (!next_unit(g, 0, cur)) return;
    f32x4 acc[2][2][4][2];
#pragma unroll
    for (int a = 0; a < 2; ++a)
#pragma unroll
        for (int b = 0; b < 2; ++b)
#pragma unroll
            for (int m = 0; m < 4; ++m)
#pragma unroll
                for (int n = 0; n < 2; ++n) acc[a][b][m][n] = (f32x4){0.f, 0.f, 0.f, 0.f};
    bf16x8 At[4][2], B0[2][2], B1[2][2];
    const char* cA = (const char*)g.A + (size_t)cur.pm * tstepA + (size_t)cur.ks * ksoff; const char* cB = (const char*)g.Bt + (size_t)cur.pn * tstepB + (size_t)cur.ks * ksoff;
    PG8_STAGE(PG8_SB(0, 0), cB, voffB); PG8_STAGE(PG8_SB(0, 1), cB + hstepB, voffB); PG8_STAGE(PG8_SA(0, 0), cA, voffA); PG8_STAGE(PG8_SA(0, 1), cA + hstepA, voffA);
    if (wr == 1) PG8_BAR;
    PG8_WAIT_V(2); PG8_BAR;
    PG8_STAGE(PG8_SB(1, 0), cB + kstep, voffB); PG8_STAGE(PG8_SA(1, 0), cA + kstep, voffA); PG8_STAGE(PG8_SB(1, 1), cB + hstepB + kstep, voffB);
    PG8_WAIT_V(6); PG8_BAR;
    for (;;) {
        const bool has_next = next_unit(g, ui + 1, nxt);
        const char* nA = has_next ? (const char*)g.A + (size_t)nxt.pm * tstepA + (size_t)nxt.ks * ksoff : cA;
        const char* nB = has_next ? (const char*)g.Bt + (size_t)nxt.pn * tstepB + (size_t)nxt.ks * ksoff : cB;
        for (int t = 0; t < nt; t += 2) {
            const bool last = (t == nt - 2);
            const char* a1 = cA + (size_t)(t + 1) * kstep;
            const char* a2 = last ? nA : cA + (size_t)(t + 2) * kstep; const char* b2 = last ? nB : cB + (size_t)(t + 2) * kstep;
            const char* a3 = a2 + kstep; const char* b3 = b2 + kstep;
            PG8_LDB(B0, 0, 0); PG8_LDB(B1, 0, 1); PG8_SCHED; PG8_LDA(At, 0, 0); PG8_STAGE(PG8_SA(1, 1), a1 + hstepA, voffA);
            PG8_WAIT_V(8); PG8_WAIT_L(0); PG8_BAR; PG8_MMA(0, 0, At, B0); PG8_MMA(0, 1, At, B1); PG8_BAR; PG8_SCHED;
            PG8_LDA(At, 0, 1); PG8_STAGE(PG8_SB(0, 0), b2, voffB); PG8_STAGE(PG8_SB(0, 1), b2 + hstepB, voffB); PG8_STAGE(PG8_SA(0, 0), a2, voffA);
            PG8_WAIT_V(8); PG8_WAIT_L(0); PG8_BAR; PG8_MMA(1, 0, At, B0); PG8_MMA(1, 1, At, B1); PG8_BAR; PG8_SCHED;
            PG8_LDB(B0, 1, 0); PG8_LDB(B1, 1, 1); PG8_SCHED; PG8_LDA(At, 1, 0); PG8_STAGE(PG8_SA(0, 1), a2 + hstepA, voffA);
            PG8_WAIT_V(8); PG8_WAIT_L(0); PG8_BAR; PG8_MMA(0, 0, At, B0); PG8_MMA(0, 1, At, B1); PG8_BAR; PG8_SCHED;
            PG8_LDA(At, 1, 1); PG8_STAGE(PG8_SB(1, 0), b3, voffB); PG8_STAGE(PG8_SB(1, 1), b3 + hstepB, voffB); PG8_STAGE(PG8_SA(1, 0), a3, voffA);
            PG8_WAIT_V(8); PG8_WAIT_L(0); PG8_BAR; PG8_MMA(1, 0, At, B0); PG8_MMA(1, 1, At, B1); PG8_BAR; PG8_SCHED;
        }
        if (wr == 0) PG8_BAR;
        E(acc, cur, wr, wc, fr, fq);
        if (!has_next) break;
#pragma unroll
        for (int a = 0; a < 2; ++a)
#pragma unroll
            for (int b = 0; b < 2; ++b)
#pragma unroll
                for (int m = 0; m < 4; ++m)
#pragma unroll
                    for (int n = 0; n < 2; ++n) acc[a][b][m][n] = (f32x4){0.f, 0.f, 0.f, 0.f};
        cur = nxt; cA = nA; cB = nB; ++ui;
        if (wr == 1) PG8_BAR;
    }
    PG8_WAIT_V(0);
    PG8_BAR;
#undef PG8_SA
#undef PG8_SB
#undef PG8_STAGE
#undef PG8_LDA
#undef PG8_LDB
#undef PG8_MMA
#undef PG8_WAIT_V
#undef PG8_WAIT_L
#undef PG8_BAR
#undef PG8_SCHED
}

template <int MODE, int ACT> struct EpiScaleBf16 {
    static constexpr bool PERM = true;
    bf16_t* O; int ldc; const float* rs;
    __device__ __forceinline__ void operator()(const f32x4 (&acc)[2][2][4][2], const Unit& u, int wr, int wc, int fr, int fq) const {
        const int row0 = u.pm * BM + wr * 64 + fr, col0 = u.pn * BM + wc * 32 + 8 * fq;
#pragma unroll
        for (int ai = 0; ai < 2; ++ai)
#pragma unroll
            for (int m = 0; m < 4; ++m) {
                const int row = row0 + ai * HALF + m * 16;
                float s = rs[row]; if (MODE == 1) s = rsqrtf(s * (1.0f / 2048.0f) + EPS);
                bf16_t* rowp = O + (size_t)row * ldc + col0;
#pragma unroll
                for (int bj = 0; bj < 2; ++bj) {
                    f32x4 v0 = acc[ai][bj][m][0] * s, v1 = acc[ai][bj][m][1] * s;
                    if (ACT == 1) {
#pragma unroll
                        for (int e = 0; e < 4; ++e) { float a = fmaxf(v0[e], 0.f), b = fmaxf(v1[e], 0.f); v0[e] = a * a; v1[e] = b * b; }
                    }
                    u32x4 w; w.x = pk2(v0[0], v0[1]); w.y = pk2(v0[2], v0[3]); w.z = pk2(v1[0], v1[1]); w.w = pk2(v1[2], v1[3]);
                    *(u32x4*)(rowp + bj * HALF) = w;
                }
            }
    }
};
template <int MODE> struct EpiResid {
    static constexpr bool PERM = false;
    const float* basef; const bf16_t* baseb; float* out; bf16_t* outb; float* sumsq;
    __device__ __forceinline__ void operator()(const f32x4 (&acc)[2][2][4][2], const Unit& u, int wr, int wc, int fr, int fq) const {
        const int row0 = u.pm * BM + wr * 64 + fr, col0 = u.pn * BM + wc * 32 + 4 * fq;
#pragma unroll
        for (int ai = 0; ai < 2; ++ai)
#pragma unroll
            for (int m = 0; m < 4; ++m) {
                const int row = row0 + ai * HALF + m * 16; const size_t off = (size_t)row * DM + col0; float ss = 0.f;
#pragma unroll
                for (int bj = 0; bj < 2; ++bj)
#pragma unroll
                    for (int n = 0; n < 2; ++n) {
                        f32x4 bs;
                        if (MODE == 0) bs = *(const f32x4*)(basef + off + bj * HALF + n * 16);
                        else { const u32x2 bw = *(const u32x2*)(baseb + off + bj * HALF + n * 16); bs = (f32x4){bflo(bw.x), bfhi(bw.x), bflo(bw.y), bfhi(bw.y)}; }
                        const f32x4 o = bs + acc[ai][bj][m][n];
                        if (MODE == 2) *(f32x4*)(out + off + bj * HALF + n * 16) = o;
                        else { u32x2 w; w.x = pk2(o[0], o[1]); w.y = pk2(o[2], o[3]); *(u32x2*)(outb + off + bj * HALF + n * 16) = w;
                            ss += (o[0] * o[0] + o[1] * o[1]) + (o[2] * o[2] + o[3] * o[3]); }
                    }
                if (MODE != 2) { ss += __shfl_xor(ss, 16); ss += __shfl_xor(ss, 32); if (fq == 0) atomicAdd(sumsq + row, ss); }
            }
    }
};
struct EpiPart {
    static constexpr bool PERM = false;
    float* part; int ldc; size_t ks_stride;
    __device__ __forceinline__ void operator()(const f32x4 (&acc)[2][2][4][2], const Unit& u, int wr, int wc, int fr, int fq) const {
        const int row0 = u.pm * BM + wr * 64 + fr, col0 = u.pn * BM + wc * 32 + 4 * fq; float* pb = part + (size_t)u.ks * ks_stride;
#pragma unroll
        for (int ai = 0; ai < 2; ++ai)
#pragma unroll
            for (int m = 0; m < 4; ++m) { const size_t off = (size_t)(row0 + ai * HALF + m * 16) * ldc + col0;
#pragma unroll
                for (int bj = 0; bj < 2; ++bj)
#pragma unroll
                    for (int n = 0; n < 2; ++n) *(f32x4*)(pb + off + bj * HALF + n * 16) = acc[ai][bj][m][n]; }
    }
};
struct EpiPartBf16 {
    static constexpr bool PERM = true;
    bf16_t* part; int ldc; size_t ks_stride;
    __device__ __forceinline__ void operator()(const f32x4 (&acc)[2][2][4][2], const Unit& u, int wr, int wc, int fr, int fq) const {
        const int row0 = u.pm * BM + wr * 64 + fr, col0 = u.pn * BM + wc * 32 + 8 * fq; bf16_t* pb = part + (size_t)u.ks * ks_stride;
#pragma unroll
        for (int ai = 0; ai < 2; ++ai)
#pragma unroll
            for (int m = 0; m < 4; ++m) { bf16_t* rowp = pb + (size_t)(row0 + ai * HALF + m * 16) * ldc + col0;
#pragma unroll
                for (int bj = 0; bj < 2; ++bj) { const f32x4 v0 = acc[ai][bj][m][0], v1 = acc[ai][bj][m][1];
                    u32x4 w; w.x = pk2(v0[0], v0[1]); w.y = pk2(v0[2], v0[3]); w.z = pk2(v1[0], v1[1]); w.w = pk2(v1[2], v1[3]); *(u32x4*)(rowp + bj * HALF) = w; } }
    }
};
}

struct Args {
    const float* in[25]; float* out; unsigned char* ws; int lo, hi;
};

__device__ __forceinline__ void p0_transpose_item(const float* __restrict__ W, int K, int N, bf16_t* __restrict__ WT, const float* __restrict__ gain, LAS float* scr, int k0, int n0, int drow0, int lane) {
    f32x4 v[16]; const int kr = lane >> 4, n4 = (lane & 15) * 4;
#pragma unroll
    for (int i = 0; i < 16; ++i) v[i] = __builtin_nontemporal_load((const f32x4*)(W + (size_t)(k0 + 4 * i + kr) * N + n0 + n4));
#pragma unroll
    for (int i = 0; i < 16; ++i) { const int kk = 4 * i + kr; const float g = gain ? gain[k0 + kk] : 1.0f; LAS float* d = scr + kk * 65 + n4;
        d[0] = v[i][0] * g; d[1] = v[i][1] * g; d[2] = v[i][2] * g; d[3] = v[i][3] * g; }
    asm volatile("s_waitcnt lgkmcnt(0)" ::: "memory");
    const int c = lane & 7;
#pragma unroll
    for (int j = 0; j < 8; ++j) { const int n = (lane >> 3) + 8 * j; const LAS float* s = scr + (8 * c) * 65 + n;
        u32x4 o; o.x = pk2(s[0 * 65], s[1 * 65]); o.y = pk2(s[2 * 65], s[3 * 65]); o.z = pk2(s[4 * 65], s[5 * 65]); o.w = pk2(s[6 * 65], s[7 * 65]);
        *(u32x4*)(WT + (size_t)(drow0 + n) * K + k0 + 8 * c) = o; }
    asm volatile("s_waitcnt lgkmcnt(0)" ::: "memory");
}
__device__ __forceinline__ bool p0_mat(int& r, const float* W, int K, int N, int ncols, bf16_t* WT, const float* gain, bool win_map, LAS float* scr, int lane) {
    const int nblk = ncols / 64, items = (K / 64) * nblk;
    if (r >= items) { r -= items; return false; }
    const int kb = r / nblk, nb = r % nblk, n0 = 64 * nb; int drow0 = n0;
    if (win_map) { const int seg = n0 >> 10; const int dseg = (seg == 1) ? 2 : (seg == 2) ? 3 : (seg == 3) ? 1 : seg; drow0 = dseg * 1024 + (n0 & 1023); }
    p0_transpose_item(W, K, N, WT, gain, scr, 64 * kb, n0, drow0, lane);
    return true;
}
__device__ __forceinline__ void p0_prologue(const Args& a, LAS unsigned char* lds) {
    const int tid = threadIdx.x, lane = tid & 63, wave = tid >> 6, G = gridDim.x;
    const int gw = blockIdx.x * 8 + wave, NGW = G * 8;
    unsigned char* ws = a.ws;
    LAS float* scr = (LAS float*)(lds + wave * 16640);
    constexpr int I_IN = 32 * 96, I_OUT = 32 * 32, I_CQ = 32 * 8, I_CKV = 32 * 16, I_CO = 8 * 32, I_UP = 32 * 128, I_DN = 128 * 32;
    constexpr int NITEMS = I_IN + I_OUT + I_CQ + I_CKV + I_CO + I_UP;
    for (int it = gw; it < NITEMS; it += NGW) {
        int r = it;
        if (p0_mat(r, a.in[4], DM, DIN, NPROJ, (bf16_t*)(ws + WS_WIN), a.in[3], true, scr, lane)) continue;
        if (p0_mat(r, a.in[14], DM, DM, DM, (bf16_t*)(ws + WS_WOUT), nullptr, false, scr, lane)) continue;
        if (p0_mat(r, a.in[17], DM, DCROSS, DCROSS, (bf16_t*)(ws + WS_WCQ), a.in[15], false, scr, lane)) continue;
        if (p0_mat(r, a.in[18], DM, 2 * DCROSS, 2 * DCROSS, (bf16_t*)(ws + WS_WCKV), a.in[16], false, scr, lane)) continue;
        if (p0_mat(r, a.in[21], DCROSS, DM, DM, (bf16_t*)(ws + WS_WCO), nullptr, false, scr, lane)) continue;
        p0_mat(r, a.in[23], DM, DFF, DFF, (bf16_t*)(ws + WS_WUP), a.in[22], false, scr, lane);
    }
    { float* z = (float*)(ws + WS_SUMSQ1); for (int i = blockIdx.x * 512 + tid; i < 2 * MTOK; i += G * 512) z[i] = 0.f; }
    __syncthreads();
    LAS float* wdt = (LAS float*)lds;
    { const float* win = a.in[4]; const float* gm = a.in[3];
      for (int k = tid; k < DM; k += 512) { const int i = k >> 8, l = (k & 255) >> 2, c = k & 3, s = (4 * i + c) * 64 + l; const float g = gm[k];
#pragma unroll
          for (int jc = 0; jc < 4; ++jc) { f32x4 w = *(const f32x4*)(win + (size_t)k * DIN + NPROJ + 4 * jc); w = w * g; *(LAS f32x4*)(wdt + s * 16 + 4 * (jc ^ ((l >> 2) & 3))) = w; } } }
    __syncthreads();
    const float* x = a.in[0]; const float* dtb = a.in[10];
    bf16_t* xb = (bf16_t*)(ws + WS_XB); float* rstd0 = (float*)(ws + WS_RSTD0); float* dtv = (float*)(ws + WS_DT);
    for (int row = gw; row < MTOK; row += NGW) {
        const f32x4* xr = (const f32x4*)(x + (size_t)row * DM) + lane;
        f32x4 v[8]; float ss = 0.f;
#pragma unroll
        for (int i = 0; i < 8; ++i) { v[i] = __builtin_nontemporal_load(xr + 64 * i); ss += (v[i][0] * v[i][0] + v[i][1] * v[i][1]) + (v[i][2] * v[i][2] + v[i][3] * v[i][3]); }
        ss = wave_sum(ss); const float rstd = rsqrtf(ss * (1.0f / DM) + EPS);
        u32x2* o8 = (u32x2*)(xb + (size_t)row * DM) + lane;
#pragma unroll
        for (int i = 0; i < 8; ++i) { u32x2 w; w.x = pk2(v[i][0], v[i][1]); w.y = pk2(v[i][2], v[i][3]); o8[64 * i] = w; }
        float acc[16];
#pragma unroll
        for (int j = 0; j < 16; ++j) acc[j] = 0.f;
#pragma unroll
        for (int i = 0; i < 8; ++i)
#pragma unroll
            for (int c = 0; c < 4; ++c) { const LAS float* wp = wdt + ((4 * i + c) * 64 + lane) * 16; const float xv = v[i][c];
#pragma unroll
                for (int jc = 0; jc < 4; ++jc) { const f32x4 w = *(const LAS f32x4*)(wp + 4 * (jc ^ ((lane >> 2) & 3)));
                    acc[4 * jc + 0] += xv * w[0]; acc[4 * jc + 1] += xv * w[1]; acc[4 * jc + 2] += xv * w[2]; acc[4 * jc + 3] += xv * w[3]; } }
        float mine = 0.f;
#pragma unroll
        for (int j = 0; j < 16; ++j) { const float t = wave_sum(acc[j]); if (lane == j) mine = t; }
        if (lane < 16) { const float xr2 = rstd * mine + dtb[lane]; dtv[(size_t)row * 16 + lane] = (xr2 > 20.f) ? xr2 : log1pf(expf(xr2)); }
        if (lane == 0) rstd0[row] = rstd;
    }
    const float* mem = a.in[1]; bf16_t* memb = (bf16_t*)(ws + WS_MEMB); float* rstdm = (float*)(ws + WS_RSTDM);
    for (int row = gw; row < MMEM; row += NGW) {
        const f32x4* xr = (const f32x4*)(mem + (size_t)row * DM) + lane;
        f32x4 v[8]; float ss = 0.f;
#pragma unroll
        for (int i = 0; i < 8; ++i) { v[i] = __builtin_nontemporal_load(xr + 64 * i); ss += (v[i][0] * v[i][0] + v[i][1] * v[i][1]) + (v[i][2] * v[i][2] + v[i][3] * v[i][3]); }
        ss = wave_sum(ss);
        u32x2* o8 = (u32x2*)(memb + (size_t)row * DM) + lane;
#pragma unroll
        for (int i = 0; i < 8; ++i) { u32x2 w; w.x = pk2(v[i][0], v[i][1]); w.y = pk2(v[i][2], v[i][3]); o8[64 * i] = w; }
        if (lane == 0) rstdm[row] = rsqrtf(ss * (1.0f / DM) + EPS);
    }
}

__device__ __forceinline__ void p2_qkprep(const Args& a) {
    bf16_t* proj = (bf16_t*)(a.ws + WS_PROJ); const int* pos = (const int*)a.in[2];
    const int gl = blockIdx.x * 512 + threadIdx.x, sub = gl & 7, NIT = (gridDim.x * 512) >> 3;
    float invf[8];
#pragma unroll
    for (int j = 0; j < 8; ++j) invf[j] = __expf(-(float)j * 0.125f * 13.122363377404328f);
    for (int item0 = gl >> 3; item0 < 2 * MTOK * 16; item0 += 4 * NIT) {
        u32x4 w[4]; bf16_t* p[4]; int mm[4], wh[4];
#pragma unroll
        for (int q = 0; q < 4; ++q) { int item = item0 + q * NIT; if (item >= 2 * MTOK * 16) item = item0;
            const int h = item & 15; mm[q] = (item >> 4) & (MTOK - 1); wh[q] = item >> 17;
            p[q] = proj + (size_t)mm[q] * NPROJ + (wh[q] ? PC_K : PC_Q) + h * 64 + 8 * sub; w[q] = *(const u32x4*)p[q]; }
#pragma unroll
        for (int q = 0; q < 4; ++q) {
            const float* gn = (wh[q] ? a.in[6] : a.in[5]) + 8 * sub;
            float v[8] = {bflo(w[q].x), bfhi(w[q].x), bflo(w[q].y), bfhi(w[q].y), bflo(w[q].z), bfhi(w[q].z), bflo(w[q].w), bfhi(w[q].w)};
            float ss = 0.f;
#pragma unroll
            for (int j = 0; j < 8; ++j) ss += v[j] * v[j];
            ss += __shfl_xor(ss, 1); ss += __shfl_xor(ss, 2); ss += __shfl_xor(ss, 4);
            const float rstd = rsqrtf(ss * (1.0f / 64.0f) + EPS);
            const f32x4 g0 = *(const f32x4*)gn, g1 = *(const f32x4*)(gn + 4);
            v[0] *= rstd * g0[0]; v[1] *= rstd * g0[1]; v[2] *= rstd * g0[2]; v[3] *= rstd * g0[3]; v[4] *= rstd * g1[0]; v[5] *= rstd * g1[1]; v[6] *= rstd * g1[2]; v[7] *= rstd * g1[3];
            const float fp = (float)pos[mm[q]];
#pragma unroll
            for (int j = 0; j < 8; ++j) {
                const float other = __shfl_xor(v[j], 1);
                if (sub < 2) {
                    const float ang = fp * invf[j]; const float n = rintf(ang * 0.15915494309189535f);
                    float r = fmaf(-n, 6.2831854820251465f, ang); r = fmaf(-n, -1.7484555e-7f, r);
                    const float sn = __sinf(r), cs = __cosf(r);
                    v[j] = (sub == 0) ? (v[j] * cs - other * sn) : (v[j] * cs + other * sn);
                }
            }
            const float sc = wh[q] ? 1.0f : 0.125f;
            u32x4 o; o.x = pk2(v[0] * sc, v[1] * sc); o.y = pk2(v[2] * sc, v[3] * sc); o.z = pk2(v[4] * sc, v[5] * sc); o.w = pk2(v[6] * sc, v[7] * sc);
            if (item0 + q * NIT < 2 * MTOK * 16) *(u32x4*)p[q] = o;
        }
    }
}

constexpr int SROW = 272;
constexpr int L_XT = 0, L_B = 69632, L_C = 104448, L_F32 = 139264, L_RED = L_F32 + 6144;
__device__ __forceinline__ void ssd_dt(LAS float* f32a, const float* dtbuf, const float* a_log, int m0, int g) {
    const int tid = threadIdx.x, hh = tid >> 7, t = tid & 127;
    LAS float* dA = f32a; LAS float* acs = f32a + 512; LAS float* dtv = f32a + 1024;
    const float dt = dtbuf[(size_t)(m0 + t) * 16 + g * 4 + hh];
    const float av = -__expf(a_log[g * 4 + hh]);
    dtv[hh * 128 + t] = dt; dA[hh * 128 + t] = dt * av;
    __syncthreads();
    const int seg = t >> 4;
    float s = 0.f;
    for (int u = 16 * seg; u <= t; ++u) s += dA[hh * 128 + u];
    acs[hh * 128 + t] = s;
    __syncthreads();
    float add = 0.f;
    for (int k = 0; k < seg; ++k) add += acs[hh * 128 + 16 * k + 15];
    __syncthreads();
    acs[hh * 128 + t] = s + add;
    __syncthreads();
}
__device__ __forceinline__ int swz(int row) { return ((row >> 3) & 15) << 3; }
template <int MODE>
__device__ __forceinline__ void ssd_build(LAS unsigned char* lds, const bf16_t* proj, const float* conv_w, const float* conv_b, int c, int m0, int g, const LAS float* wgt) {
    const int tid = threadIdx.x, ch = tid & 63, s0 = (tid >> 6) * 16;
    if (MODE == 0 && ch >= 48) return;
    const int cb = (ch < 32) ? (g * 256 + ch * 8) : (ch < 48) ? (1024 + g * 128 + (ch - 32) * 8) : (1536 + g * 128 + (ch - 48) * 8);
    f32x2 cw2[4][4], bias2[4];
#pragma unroll
    for (int w = 0; w < 4; ++w) { const f32x4 w0 = *(const f32x4*)(conv_w + w * 2048 + cb), w1 = *(const f32x4*)(conv_w + w * 2048 + cb + 4);
        cw2[w][0] = (f32x2){w0[0], w0[1]}; cw2[w][1] = (f32x2){w0[2], w0[3]}; cw2[w][2] = (f32x2){w1[0], w1[1]}; cw2[w][3] = (f32x2){w1[2], w1[3]}; }
    { const f32x4 b0 = *(const f32x4*)(conv_b + cb), b1 = *(const f32x4*)(conv_b + cb + 4);
      bias2[0] = (f32x2){b0[0], b0[1]}; bias2[1] = (f32x2){b0[2], b0[3]}; bias2[2] = (f32x2){b1[0], b1[1]}; bias2[3] = (f32x2){b1[2], b1[3]}; }
#pragma unroll 1
    for (int half = 0; half < 2; ++half) {
        const int sh = s0 + 8 * half;
        const bf16_t* src = proj + (size_t)(m0 + sh) * NPROJ + PC_X + cb;
        u32x4 raw[11];
#pragma unroll
        for (int i = 0; i < 11; ++i) { const int tpos = c * 128 + sh - 3 + i; raw[i] = (tpos >= 0) ? *(const u32x4*)(src + (ptrdiff_t)(i - 3) * NPROJ) : (u32x4){0u, 0u, 0u, 0u}; }
        f32x2 win2[4][4];
#pragma unroll
        for (int i = 0; i < 3; ++i) { win2[i][0] = (f32x2){bflo(raw[i].x), bfhi(raw[i].x)}; win2[i][1] = (f32x2){bflo(raw[i].y), bfhi(raw[i].y)};
            win2[i][2] = (f32x2){bflo(raw[i].z), bfhi(raw[i].z)}; win2[i][3] = (f32x2){bflo(raw[i].w), bfhi(raw[i].w)}; }
#pragma unroll
        for (int t = 0; t < 8; ++t) {
            const int s = sh + t; const int cur = (t + 3) & 3;
            win2[cur][0] = (f32x2){bflo(raw[t + 3].x), bfhi(raw[t + 3].x)}; win2[cur][1] = (f32x2){bflo(raw[t + 3].y), bfhi(raw[t + 3].y)};
            win2[cur][2] = (f32x2){bflo(raw[t + 3].z), bfhi(raw[t + 3].z)}; win2[cur][3] = (f32x2){bflo(raw[t + 3].w), bfhi(raw[t + 3].w)};
            float acc[8];
#pragma unroll
            for (int i = 0; i < 4; ++i) { f32x2 v = bias2[i];
#pragma unroll
                for (int w = 0; w < 4; ++w) v = cw2[w][i] * win2[(t + w) & 3][i] + v;
                const f32x2 ng = v * (-1.4426950408889634f); f32x2 d; d.x = __builtin_amdgcn_exp2f(ng.x); d.y = __builtin_amdgcn_exp2f(ng.y); d = d + 1.0f;
                f32x2 rc; rc.x = __builtin_amdgcn_rcpf(d.x); rc.y = __builtin_amdgcn_rcpf(d.y); const f32x2 o = v * rc;
                acc[2 * i] = o.x; acc[2 * i + 1] = o.y; }
            if (ch < 32) {
                const int hh = ch >> 3; float sc = 1.0f; if (MODE == 0) sc = wgt[hh * 128 + s];
                const int col = s ^ swz(ch * 8);
#pragma unroll
                for (int e = 0; e < 8; e += 2) { const unsigned w = pk2(acc[e] * sc, acc[e + 1] * sc);
                    *(LAS unsigned short*)(lds + L_XT + (ch * 8 + e) * SROW + col * 2) = (unsigned short)(w & 0xffffu);
                    *(LAS unsigned short*)(lds + L_XT + (ch * 8 + e + 1) * SROW + col * 2) = (unsigned short)(w >> 16); }
            } else if (MODE == 0) {
                const int col = s ^ swz((ch - 32) * 8);
#pragma unroll
                for (int e = 0; e < 8; e += 2) { const unsigned w = pk2(acc[e], acc[e + 1]);
                    *(LAS unsigned short*)(lds + L_B + ((ch - 32) * 8 + e) * SROW + col * 2) = (unsigned short)(w & 0xffffu);
                    *(LAS unsigned short*)(lds + L_B + ((ch - 32) * 8 + e + 1) * SROW + col * 2) = (unsigned short)(w >> 16); }
            } else {
                u32x4 w; w.x = pk2(acc[0], acc[1]); w.y = pk2(acc[2], acc[3]); w.z = pk2(acc[4], acc[5]); w.w = pk2(acc[6], acc[7]);
                const int off = (ch < 48) ? (L_B + s * SROW + (ch - 32) * 16) : (L_C + s * SROW + (ch - 48) * 16);
                *(LAS u32x4*)(lds + off) = w;
            }
        }
    }
}

__device__ __forceinline__ void p2_ssd_states(const Args& a, LAS unsigned char* lds) {
    const int tid = threadIdx.x, lane = tid & 63, wid = tid >> 6, l31 = lane & 31, hi = lane >> 5;
    const bf16_t* proj = (const bf16_t*)(a.ws + WS_PROJ); const float* dtbuf = (const float*)(a.ws + WS_DT);
    float* states = (float*)(a.ws + WS_STATES); float* atot = (float*)(a.ws + WS_ATOT);
    LAS float* f32a = (LAS float*)(lds + L_C);
    for (int unit = blockIdx.x; unit < 256; unit += gridDim.x) {
        const int g = unit & 3, c = (unit >> 2) & 15, b = unit >> 6, m0 = b * SEQ + c * 128;
        __syncthreads();
        ssd_dt(f32a, dtbuf, a.in[11], m0, g);
        { const int hh = tid >> 7, t = tid & 127; const float at = f32a[512 + hh * 128 + 127];
          f32a[1536 + hh * 128 + t] = __expf(at - f32a[512 + hh * 128 + t]) * f32a[1024 + hh * 128 + t];
          if (t == 127) atot[(b * 16 + c) * 16 + g * 4 + hh] = at; }
        __syncthreads();
        ssd_build<0>(lds, proj, a.in[8], a.in[9], c, m0, g, f32a + 1536);
        __syncthreads();
        const int hh = wid >> 1, pb = wid & 1;
        f32x16 acc[4];
#pragma unroll
        for (int nb = 0; nb < 4; ++nb) acc[nb] = zero16();
#pragma unroll
        for (int ks = 0; ks < 8; ++ks) {
            const bf16x8 af = *(const LAS bf16x8*)(lds + L_XT + (hh * 64 + 32 * pb + l31) * SROW + ((16 * ks + 8 * hi) ^ swz(hh * 64 + 32 * pb + l31)) * 2);
#pragma unroll
            for (int nb = 0; nb < 4; ++nb) { const bf16x8 bf = *(const LAS bf16x8*)(lds + L_B + (32 * nb + l31) * SROW + ((16 * ks + 8 * hi) ^ swz(32 * nb + l31)) * 2); acc[nb] = MFMA32(af, bf, acc[nb]); }
        }
        float* st = states + (size_t)((b * 16 + c) * 16 + g * 4 + hh) * 8192;
#pragma unroll
        for (int nb = 0; nb < 4; ++nb)
#pragma unroll
            for (int r = 0; r < 16; ++r) { const int p = 32 * pb + (r & 3) + 8 * (r >> 2) + 4 * hi; st[p * 128 + 32 * nb + l31] = acc[nb][r]; }
    }
}

__device__ __forceinline__ void p3_scan(const Args& a) {
    const int tid = threadIdx.x, lane = tid & 63, wid = tid >> 6;
    const float* states = (const float*)(a.ws + WS_STATES); const float* atot = (const float*)(a.ws + WS_ATOT); bf16_t* prevb = (bf16_t*)a.out;
    const int gw = blockIdx.x * 8 + wid, NGW = gridDim.x * 8;
    for (int it = gw; it < 2048; it += NGW) {
        const int b = it >> 9, head = (it >> 5) & 15, prp = it & 31; const size_t eoff = (size_t)prp * 256 + lane * 4;
        f32x4 s[16]; float dec[16];
#pragma unroll
        for (int c = 0; c < 16; ++c) { s[c] = *(const f32x4*)(states + (size_t)((b * 16 + c) * 16 + head) * 8192 + eoff); dec[c] = __expf(atot[(b * 16 + c) * 16 + head]); }
        f32x4 h = (f32x4){0.f, 0.f, 0.f, 0.f};
#pragma unroll
        for (int c = 0; c < 16; ++c) { u32x2 w; w.x = pk2(h[0], h[1]); w.y = pk2(h[2], h[3]);
            *(u32x2*)(prevb + (size_t)((b * 16 + c) * 16 + head) * 8192 + eoff) = w; h = h * dec[c] + s[c]; }
    }
}

__device__ __forceinline__ void p3_ssd_out(const Args& a, LAS unsigned char* lds) {
    const int tid = threadIdx.x, lane = tid & 63, wid = tid >> 6, l31 = lane & 31, hi = lane >> 5;
    bf16_t* proj = (bf16_t*)(a.ws + WS_PROJ); const float* dtbuf = (const float*)(a.ws + WS_DT);
    const bf16_t* prevb = (const bf16_t*)a.out;
    LAS float* f32a = (LAS float*)(lds + L_F32); LAS float* acs = f32a + 512; LAS float* dtl = f32a + 1024; LAS float* red = (LAS float*)(lds + L_RED);
    for (int unit = blockIdx.x; unit < 256; unit += gridDim.x) {
        const int g = unit & 3, c = (unit >> 2) & 15, b = unit >> 6, m0 = b * SEQ + c * 128;
        __syncthreads();
        ssd_dt(f32a, dtbuf, a.in[11], m0, g);
        ssd_build<1>(lds, proj, a.in[8], a.in[9], c, m0, g, nullptr);
        __syncthreads();
        const int hh = wid >> 1, pb = wid & 1, head = g * 4 + hh, prow = 32 * pb + l31;
        bf16x8 pf[8];
        { const bf16_t* pp = prevb + (size_t)((b * 16 + c) * 16 + head) * 8192 + prow * 128 + 8 * hi;
#pragma unroll
          for (int ks = 0; ks < 8; ++ks) pf[ks] = *(const bf16x8*)(pp + 16 * ks); }
        const float dsk = a.in[12][head];
        u32x2 zw[4][4];
#pragma unroll
        for (int lb = 0; lb < 4; ++lb) { const bf16_t* zrow = proj + (size_t)(m0 + 32 * lb + l31) * NPROJ + PC_Z + head * 64 + 32 * pb + 4 * hi;
#pragma unroll
            for (int rg = 0; rg < 4; ++rg) zw[lb][rg] = *(const u32x2*)(zrow + 8 * rg); }
        f32x16 y[4];
#pragma unroll
        for (int lb = 0; lb < 4; ++lb) {
            bf16x8 cf[8];
#pragma unroll
            for (int ks = 0; ks < 8; ++ks) cf[ks] = *(const LAS bf16x8*)(lds + L_C + (32 * lb + l31) * SROW + (16 * ks + 8 * hi) * 2);
            f32x16 acc = zero16();
#pragma unroll
            for (int ks = 0; ks < 8; ++ks) acc = MFMA32(pf[ks], cf[ks], acc);
            const int l = 32 * lb + l31; const float al = acs[hh * 128 + l]; const float el = __expf(al);
#pragma unroll
            for (int r = 0; r < 16; ++r) acc[r] *= el;
            for (int sb = 0; sb <= lb; ++sb) {
                f32x16 cbt = zero16();
#pragma unroll
                for (int ks = 0; ks < 8; ++ks) { const bf16x8 bfr = *(const LAS bf16x8*)(lds + L_B + (32 * sb + l31) * SROW + (16 * ks + 8 * hi) * 2); cbt = MFMA32(bfr, cf[ks], cbt); }
                float wv[16];
#pragma unroll
                for (int rg = 0; rg < 4; ++rg) { const int s0 = 32 * sb + 8 * rg + 4 * hi;
                    const f32x4 as4 = *(const LAS f32x4*)(acs + hh * 128 + s0), dt4 = *(const LAS f32x4*)(dtl + hh * 128 + s0);
#pragma unroll
                    for (int e = 0; e < 4; ++e) { const float v = cbt[4 * rg + e] * __expf(al - as4[e]) * dt4[e]; wv[4 * rg + e] = (s0 + e <= l) ? v : 0.f; } }
                const bf16x8 w0 = pack8(wv[0], wv[1], wv[2], wv[3], wv[4], wv[5], wv[6], wv[7]);
                const bf16x8 w1 = pack8(wv[8], wv[9], wv[10], wv[11], wv[12], wv[13], wv[14], wv[15]);
                const LAS unsigned char* xrowb = lds + L_XT + (hh * 64 + prow) * SROW; const int xs_ = swz(hh * 64 + prow), c0_ = 32 * sb + 4 * hi;
                { const s16x4 lo = *(const LAS s16x4*)(xrowb + ((c0_) ^ xs_) * 2), hi4 = *(const LAS s16x4*)(xrowb + ((c0_ + 8) ^ xs_) * 2);
                  bf16x8 af; af[0] = lo[0]; af[1] = lo[1]; af[2] = lo[2]; af[3] = lo[3]; af[4] = hi4[0]; af[5] = hi4[1]; af[6] = hi4[2]; af[7] = hi4[3];
                  acc = MFMA32(af, w0, acc); }
                { const s16x4 lo = *(const LAS s16x4*)(xrowb + ((c0_ + 16) ^ xs_) * 2), hi4 = *(const LAS s16x4*)(xrowb + ((c0_ + 24) ^ xs_) * 2);
                  bf16x8 af; af[0] = lo[0]; af[1] = lo[1]; af[2] = lo[2]; af[3] = lo[3]; af[4] = hi4[0]; af[5] = hi4[1]; af[6] = hi4[2]; af[7] = hi4[3];
                  acc = MFMA32(af, w1, acc); }
            }
            float ss = 0.f;
#pragma unroll
            for (int rg = 0; rg < 4; ++rg) { const u32x2 zq = zw[lb][rg];
                const float zf[4] = {bflo(zq.x), bfhi(zq.x), bflo(zq.y), bfhi(zq.y)};
#pragma unroll
                for (int e = 0; e < 4; ++e) { const int p = 32 * pb + 8 * rg + 4 * hi + e;
                    const float xv = __uint_as_float((unsigned)(*(const LAS unsigned short*)(lds + L_XT + (hh * 64 + p) * SROW + (l ^ swz(hh * 64 + p)) * 2)) << 16);
                    float v = acc[4 * rg + e] + dsk * xv; v *= zf[e] * __builtin_amdgcn_rcpf(1.0f + __expf(-zf[e])); acc[4 * rg + e] = v; ss += v * v; } }
            ss += __shfl_xor(ss, 32);
            if (hi == 0) red[wid * 128 + l] = ss;
            y[lb] = acc;
        }
        __syncthreads();
        const float* gso = a.in[13] + head * 64 + 32 * pb + 4 * hi;
#pragma unroll
        for (int lb = 0; lb < 4; ++lb) { const int l = 32 * lb + l31; float tot = 0.f;
#pragma unroll
            for (int w = 0; w < 8; ++w) tot += red[w * 128 + l];
            const float rstd = rsqrtf(tot * (1.0f / 256.0f) + EPS);
            bf16_t* orow = proj + (size_t)(m0 + l) * NPROJ + PC_Z + head * 64 + 32 * pb + 4 * hi;
#pragma unroll
            for (int rg = 0; rg < 4; ++rg) { const f32x4 g4 = *(const f32x4*)(gso + 8 * rg);
                u32x2 w; w.x = pk2(y[lb][4 * rg] * rstd * g4[0], y[lb][4 * rg + 1] * rstd * g4[1]); w.y = pk2(y[lb][4 * rg + 2] * rstd * g4[2], y[lb][4 * rg + 3] * rstd * g4[3]);
                *(u32x2*)(orow + 8 * rg) = w; } }
    }
}

constexpr int AKROW = 144, AVROW = 784, LA_K = 0, LA_V = 384 * AKROW, ATT_UNITS = 3 * 512;
__device__ __forceinline__ int attn_row_token(int br, int blk, int j) {
    if (br == 0) { return 256 * blk - 128 + j; }
    if (br == 1) { const int idx = 256 * (blk & 1) - 128 + j; return idx < 0 ? -1 : (blk >> 1) + 4 * idx; }
    if (j >= 256) return -1;
    return 2 * blk + (j >> 7) + 16 * (j & 127);
}
__device__ __forceinline__ void attn_load(const bf16_t* proj, int u, u32x4 (&kr)[6], u32x4 (&vr)[6]) {
    const int tid = threadIdx.x, blk = u & 7, hd = (u >> 3) & 15, b = (u >> 7) & 3, br = u >> 9;
#pragma unroll
    for (int i = 0; i < 6; ++i) {
        const int c = tid + 512 * i;
        { const int j = c >> 3, cc = c & 7, t = attn_row_token(br, blk, j);
          kr[i] = (t >= 0) ? *(const u32x4*)(proj + ((size_t)b * SEQ + t) * NPROJ + PC_K + hd * 64 + cc * 8) : (u32x4){0u, 0u, 0u, 0u}; }
        { const int j = c >> 3, cc = c & 7, t = attn_row_token(br, blk, j);
          vr[i] = (t >= 0) ? *(const u32x4*)(proj + ((size_t)b * SEQ + t) * NPROJ + PC_V + hd * 64 + cc * 8) : (u32x4){0u, 0u, 0u, 0u}; }
    }
}
__device__ __forceinline__ void attn_store(LAS unsigned char* lds, const u32x4 (&kr)[6], const u32x4 (&vr)[6]) {
    const int tid = threadIdx.x;
#pragma unroll
    for (int i = 0; i < 6; ++i) {
        const int c = tid + 512 * i;
        { const int j = c >> 3, cc = c & 7; *(LAS u32x4*)(lds + LA_K + j * AKROW + cc * 16) = kr[i]; }
        { const int j = c >> 3, cc = c & 7, col = j ^ (8 * cc); const unsigned wv[4] = {vr[i].x, vr[i].y, vr[i].z, vr[i].w};
#pragma unroll
          for (int e = 0; e < 4; ++e) { *(LAS unsigned short*)(lds + LA_V + (cc * 8 + 2 * e) * AVROW + col * 2) = (unsigned short)(wv[e] & 0xffffu);
              *(LAS unsigned short*)(lds + LA_V + (cc * 8 + 2 * e + 1) * AVROW + col * 2) = (unsigned short)(wv[e] >> 16); } }
    }
}
__device__ __forceinline__ void p3_attn(const Args& a, LAS unsigned char* lds) {
    const int tid = threadIdx.x, lane = tid & 63, wid = tid >> 6, l31 = lane & 31, hi = lane >> 5;
    const bf16_t* proj = (const bf16_t*)(a.ws + WS_PROJ); bf16_t* obr = (bf16_t*)(a.ws + WS_OBR); float* lse = (float*)(a.ws + WS_LSE);
    unsigned* qctr = (unsigned*)(a.ws + WS_BAR) + 3584;
    const unsigned myx = ((unsigned)__builtin_amdgcn_s_getreg((3 << 11) | 20)) & 7u;
#define ATT_FETCH() do { unsigned got_ = (unsigned)ATT_UNITS; \
        for (unsigned t_ = 0; t_ < 8u; ++t_) { const unsigned xq_ = (myx + t_) & 7u; const unsigned i_ = atomicAdd(qctr + 64 * xq_, 1u); \
            if (i_ < 192u) { const unsigned p_ = xq_ + 8u * (i_ / 24u), sub_ = i_ % 24u; got_ = (sub_ >> 3) * 512u + p_ * 8u + (sub_ & 7u); break; } } \
        qnext[0] = got_; } while (0)
    volatile LAS unsigned* qnext = (volatile LAS unsigned*)(lds + LDS_BYTES - 32);
    u32x4 kr[6], vr[6];
    __syncthreads();
    if (tid == 0) ATT_FETCH();
    __syncthreads();
    int u = (int)qnext[0];
    bf16x8 qn[4];
#define ATT_GEOM(uu, tq_, rowt0_, kt0_) do { const int blk_ = (uu) & 7, br_ = (uu) >> 9; \
        if (br_ < 2) { const int base_q = (br_ == 0) ? 256 * blk_ : 256 * (blk_ & 1), r_ = (br_ == 0) ? 0 : (blk_ >> 1), d_ = (br_ == 0) ? 1 : 4; \
            tq_ = r_ + d_ * (base_q + 32 * wid + l31); rowt0_ = 32 * wid; const int q32 = (base_q >> 5) + wid; kt0_ = (q32 >= 4) ? 0 : 4 - q32; } \
        else { const int rsel = wid >> 2, wq = wid & 3; tq_ = 2 * blk_ + rsel + 16 * (32 * wq + l31); rowt0_ = 128 * rsel + 32 * wq - 128; kt0_ = 4 - wq; } } while (0)
#define ATT_QLOAD(uu) do { int tq_, r0_, k0_; ATT_GEOM(uu, tq_, r0_, k0_); (void)r0_; (void)k0_; const size_t mq_ = (size_t)(((uu) >> 7) & 3) * SEQ + tq_; \
        _Pragma("unroll") for (int kk = 0; kk < 4; ++kk) qn[kk] = *(const bf16x8*)(proj + mq_ * NPROJ + PC_Q + (((uu) >> 3) & 15) * 64 + 16 * kk + 8 * hi); } while (0)
    if (u < ATT_UNITS) { attn_load(proj, u, kr, vr); ATT_QLOAD(u); }
    while (u < ATT_UNITS) {
        __syncthreads();
        attn_store(lds, kr, vr);
        if (tid == 0) ATT_FETCH();
        __syncthreads();
        const int un = (int)qnext[0];
        bf16x8 qf[4];
#pragma unroll
        for (int kk = 0; kk < 4; ++kk) qf[kk] = qn[kk];
        if (un < ATT_UNITS) { attn_load(proj, un, kr, vr); ATT_QLOAD(un); }
        const int blk = u & 7, hd = (u >> 3) & 15, b = (u >> 7) & 3, br = u >> 9;
        int tq, rowt0, kt0; ATT_GEOM(u, tq, rowt0, kt0);
        const size_t mq = (size_t)b * SEQ + tq;
        float m_run = -INFINITY, l_run = 0.f; f32x16 acc[2]; acc[0] = zero16(); acc[1] = zero16();
        for (int kt = kt0; kt < 5; ++kt) {
            const int row0 = rowt0 + 32 * kt;
            f32x16 st = zero16();
#pragma unroll
            for (int kk = 0; kk < 4; ++kk) { const bf16x8 kf = *(const LAS bf16x8*)(lds + LA_K + (row0 + l31) * AKROW + (16 * kk + 8 * hi) * 2); st = MFMA32(kf, qf[kk], st); }
            const int dbase = 128 - 32 * kt + l31 - 4 * hi; float mx = -INFINITY;
#pragma unroll
            for (int rr = 0; rr < 16; ++rr) { const int dist = dbase - ((rr & 3) + 8 * (rr >> 2)); const bool ok = (dist >= 0) && (dist <= 128); st[rr] = ok ? st[rr] : -INFINITY; mx = fmaxf(mx, st[rr]); }
            mx = fmaxf(mx, __shfl_xor(mx, 32));
            const float m_new = fmaxf(m_run, mx), alpha = __expf(m_run - m_new); float psum = 0.f;
#pragma unroll
            for (int rr = 0; rr < 16; ++rr) { st[rr] = __expf(st[rr] - m_new); psum += st[rr]; }
            psum += __shfl_xor(psum, 32);
            l_run = l_run * alpha + psum; m_run = m_new;
#pragma unroll
            for (int rr = 0; rr < 16; ++rr) { acc[0][rr] *= alpha; acc[1][rr] *= alpha; }
            const bf16x8 p0 = pack8(st[0], st[1], st[2], st[3], st[4], st[5], st[6], st[7]);
            const bf16x8 p1 = pack8(st[8], st[9], st[10], st[11], st[12], st[13], st[14], st[15]);
#pragma unroll
            for (int db = 0; db < 2; ++db) {
                const LAS unsigned char* vrowb = lds + LA_V + (32 * db + l31) * AVROW; const int vsw = 8 * (((32 * db + l31) >> 3) & 7), vc0 = row0 + 4 * hi;
                { const s16x4 lo = *(const LAS s16x4*)(vrowb + ((vc0) ^ vsw) * 2), h4 = *(const LAS s16x4*)(vrowb + ((vc0 + 8) ^ vsw) * 2);
                  bf16x8 af; af[0] = lo[0]; af[1] = lo[1]; af[2] = lo[2]; af[3] = lo[3]; af[4] = h4[0]; af[5] = h4[1]; af[6] = h4[2]; af[7] = h4[3];
                  acc[db] = MFMA32(af, p0, acc[db]); }
                { const s16x4 lo = *(const LAS s16x4*)(vrowb + ((vc0 + 16) ^ vsw) * 2), h4 = *(const LAS s16x4*)(vrowb + ((vc0 + 24) ^ vsw) * 2);
                  bf16x8 af; af[0] = lo[0]; af[1] = lo[1]; af[2] = lo[2]; af[3] = lo[3]; af[4] = h4[0]; af[5] = h4[1]; af[6] = h4[2]; af[7] = h4[3];
                  acc[db] = MFMA32(af, p1, acc[db]); }
            }
        }
        const float inv = 1.0f / l_run;
        bf16_t* op = obr + ((size_t)br * MTOK + mq) * 1024 + hd * 64 + 4 * hi;
#pragma unroll
        for (int db = 0; db < 2; ++db)
#pragma unroll
            for (int rg = 0; rg < 4; ++rg) { u32x2 w; w.x = pk2(acc[db][4 * rg] * inv, acc[db][4 * rg + 1] * inv); w.y = pk2(acc[db][4 * rg + 2] * inv, acc[db][4 * rg + 3] * inv);
                *(u32x2*)(op + 32 * db + 8 * rg) = w; }
        if (hi == 0) lse[((size_t)br * MTOK + mq) * 16 + hd] = m_run + __logf(l_run);
        u = un;
    }
}

__device__ __forceinline__ void p4_combine(const Args& a) {
    const int tid = threadIdx.x, lane = tid & 63, wid = tid >> 6;
    bf16_t* proj = (bf16_t*)(a.ws + WS_PROJ); const bf16_t* obr = (const bf16_t*)(a.ws + WS_OBR); const float* lse = (const float*)(a.ws + WS_LSE);
    const float* gao = a.in[7];
    const int gw = blockIdx.x * 8 + wid, NGW = gridDim.x * 8;
    for (int m = gw; m < MTOK; m += NGW) {
        const int hd = lane >> 2;
        const float l0 = lse[((size_t)0 * MTOK + m) * 16 + hd], l1 = lse[((size_t)1 * MTOK + m) * 16 + hd], l2 = lse[((size_t)2 * MTOK + m) * 16 + hd];
        const float mx = fmaxf(l0, fmaxf(l1, l2)); const float e0 = __expf(l0 - mx), e1 = __expf(l1 - mx), e2 = __expf(l2 - mx); const float inv = 1.0f / (e0 + e1 + e2);
        const float wg[3] = {e0 * inv, e1 * inv, e2 * inv};
        float v[16];
#pragma unroll
        for (int e = 0; e < 16; ++e) v[e] = 0.f;
#pragma unroll
        for (int gI = 0; gI < 3; ++gI) { const bf16_t* p = obr + ((size_t)gI * MTOK + m) * 1024 + lane * 16;
#pragma unroll
            for (int c = 0; c < 2; ++c) { const u32x4 w = *(const u32x4*)(p + 8 * c);
                v[8 * c + 0] += wg[gI] * bflo(w.x); v[8 * c + 1] += wg[gI] * bfhi(w.x); v[8 * c + 2] += wg[gI] * bflo(w.y); v[8 * c + 3] += wg[gI] * bfhi(w.y);
                v[8 * c + 4] += wg[gI] * bflo(w.z); v[8 * c + 5] += wg[gI] * bfhi(w.z); v[8 * c + 6] += wg[gI] * bflo(w.w); v[8 * c + 7] += wg[gI] * bfhi(w.w); } }
        float ss = 0.f;
#pragma unroll
        for (int e = 0; e < 16; ++e) ss += v[e] * v[e];
        ss = wave_sum(ss); const float rstd = rsqrtf(ss * (1.0f / 1024.0f) + EPS);
        bf16_t* op = proj + (size_t)m * NPROJ + PC_Q + lane * 16;
#pragma unroll
        for (int c = 0; c < 2; ++c) { const f32x4 g0 = *(const f32x4*)(gao + lane * 16 + 8 * c), g1 = *(const f32x4*)(gao + lane * 16 + 8 * c + 4);
            u32x4 w; w.x = pk2(v[8 * c] * rstd * g0[0], v[8 * c + 1] * rstd * g0[1]); w.y = pk2(v[8 * c + 2] * rstd * g0[2], v[8 * c + 3] * rstd * g0[3]);
            w.z = pk2(v[8 * c + 4] * rstd * g1[0], v[8 * c + 5] * rstd * g1[1]); w.w = pk2(v[8 * c + 6] * rstd * g1[2], v[8 * c + 7] * rstd * g1[3]);
            *(u32x4*)(op + 8 * c) = w; }
    }
}

__device__ __forceinline__ void p5_kvprep(const Args& a) {
    const int tid = threadIdx.x, lane = tid & 63, wid = tid >> 6;
    const float* kvp = (const float*)(a.ws + WS_KVPART); const float* rstdm = (const float*)(a.ws + WS_RSTDM);
    bf16_t* kc = (bf16_t*)(a.ws + WS_KC); bf16_t* vct = (bf16_t*)(a.ws + WS_VCT); const float* gck = a.in[20];
    const int gw = blockIdx.x * 8 + wid, NGW = gridDim.x * 8;
    for (int it = gw; it < MMEM * 4; it += NGW) {
        const int mm = it >> 2, h = it & 3, b = mm >> 8, j = mm & 255; const float rs = rstdm[mm];
        float k0 = 0.f, k1 = 0.f, v0 = 0.f, v1 = 0.f;
#pragma unroll
        for (int ks = 0; ks < 2; ++ks) { const float* p = kvp + ((size_t)ks * MMEM + mm) * 1024 + h * 128 + 2 * lane;
            const f32x2 kk = *(const f32x2*)p, vv = *(const f32x2*)(p + 512); k0 += kk[0]; k1 += kk[1]; v0 += vv[0]; v1 += vv[1]; }
        k0 *= rs; k1 *= rs; v0 *= rs; v1 *= rs;
        const float ss = wave_sum(k0 * k0 + k1 * k1); const float r = rsqrtf(ss * (1.0f / 128.0f) + EPS);
        *(unsigned*)(kc + ((size_t)(b * 4 + h) * 256 + j) * 128 + 2 * lane) = pk2(k0 * r * gck[2 * lane], k1 * r * gck[2 * lane + 1]);
        vct[((size_t)(b * 4 + h) * 128 + 2 * lane) * 256 + j] = (bf16_t)f2bf(v0);
        vct[((size_t)(b * 4 + h) * 128 + 2 * lane + 1) * 256 + j] = (bf16_t)f2bf(v1);
    }
}

constexpr int KROW = 272, VTROW = 528, LX_K = 0, LX_V = 256 * KROW;
__device__ __forceinline__ void p6_cross(const Args& a, LAS unsigned char* lds) {
    const int tid = threadIdx.x, lane = tid & 63, wid = tid >> 6, l31 = lane & 31, hi = lane >> 5;
    const bf16_t* qp = (const bf16_t*)(a.ws + WS_QPART); const float* sumsq1 = (const float*)(a.ws + WS_SUMSQ1);
    const bf16_t* kc = (const bf16_t*)(a.ws + WS_KC); const bf16_t* vct = (const bf16_t*)(a.ws + WS_VCT); bf16_t* co = (bf16_t*)(a.ws + WS_CO);
    const float* gcq = a.in[19];
    for (int u = blockIdx.x; u < 128; u += gridDim.x) {
        const int qb8 = u & 7, h = (u >> 3) & 3, b = u >> 5; const size_t mq = (size_t)b * SEQ + 256 * qb8 + 32 * wid + l31;
        __syncthreads();
        { const bf16_t* kbase = kc + (size_t)(b * 4 + h) * 256 * 128; const bf16_t* vbase = vct + (size_t)(b * 4 + h) * 128 * 256;
#pragma unroll
          for (int i = 0; i < 8; ++i) { const int ch = tid + 512 * i; const int row = ch >> 4, c16 = ch & 15; *(LAS u32x4*)(lds + LX_K + row * KROW + c16 * 16) = *(const u32x4*)(kbase + row * 128 + c16 * 8); }
#pragma unroll
          for (int i = 0; i < 8; ++i) { const int ch = tid + 512 * i; const int row = ch >> 5, c16 = ch & 31; *(LAS u32x4*)(lds + LX_V + row * VTROW + c16 * 16) = *(const u32x4*)(vbase + row * 256 + c16 * 8); } }
        const float rs1 = rsqrtf(sumsq1[mq] * (1.0f / DM) + EPS);
        bf16x8 qf[8];
        { float qv[8][8]; float ss = 0.f;
#pragma unroll
          for (int kk = 0; kk < 8; ++kk) {
#pragma unroll
              for (int j = 0; j < 8; ++j) qv[kk][j] = 0.f;
#pragma unroll
              for (int ks = 0; ks < 4; ++ks) { const u32x4 w = *(const u32x4*)(qp + ((size_t)ks * MTOK + mq) * DCROSS + h * 128 + 16 * kk + 8 * hi);
                  qv[kk][0] += bflo(w.x); qv[kk][1] += bfhi(w.x); qv[kk][2] += bflo(w.y); qv[kk][3] += bfhi(w.y); qv[kk][4] += bflo(w.z); qv[kk][5] += bfhi(w.z); qv[kk][6] += bflo(w.w); qv[kk][7] += bfhi(w.w); }
#pragma unroll
              for (int j = 0; j < 8; ++j) { qv[kk][j] *= rs1; ss += qv[kk][j] * qv[kk][j]; } }
          ss += __shfl_xor(ss, 32);
          const float r = rsqrtf(ss * (1.0f / 128.0f) + EPS) * 0.08838834764831845f;
#pragma unroll
          for (int kk = 0; kk < 8; ++kk) { const f32x4 g0 = *(const f32x4*)(gcq + 16 * kk + 8 * hi), g1 = *(const f32x4*)(gcq + 16 * kk + 8 * hi + 4);
              qf[kk] = pack8(qv[kk][0] * r * g0[0], qv[kk][1] * r * g0[1], qv[kk][2] * r * g0[2], qv[kk][3] * r * g0[3], qv[kk][4] * r * g1[0], qv[kk][5] * r * g1[1], qv[kk][6] * r * g1[2], qv[kk][7] * r * g1[3]); }
        }
        __syncthreads();
        float m_run = -INFINITY, l_run = 0.f; f32x16 acc[4];
#pragma unroll
        for (int db = 0; db < 4; ++db) acc[db] = zero16();
        for (int kt = 0; kt < 8; ++kt) {
            f32x16 st = zero16();
#pragma unroll
            for (int kk = 0; kk < 8; ++kk) { const bf16x8 kf = *(const LAS bf16x8*)(lds + LX_K + (32 * kt + l31) * KROW + (16 * kk + 8 * hi) * 2); st = MFMA32(kf, qf[kk], st); }
            float mx = -INFINITY;
#pragma unroll
            for (int rr = 0; rr < 16; ++rr) mx = fmaxf(mx, st[rr]);
            mx = fmaxf(mx, __shfl_xor(mx, 32));
            const float m_new = fmaxf(m_run, mx), alpha = __expf(m_run - m_new); float psum = 0.f;
#pragma unroll
            for (int rr = 0; rr < 16; ++rr) { st[rr] = __expf(st[rr] - m_new); psum += st[rr]; }
            psum += __shfl_xor(psum, 32);
            l_run = l_run * alpha + psum; m_run = m_new;
            const bf16x8 p0 = pack8(st[0], st[1], st[2], st[3], st[4], st[5], st[6], st[7]);
            const bf16x8 p1 = pack8(st[8], st[9], st[10], st[11], st[12], st[13], st[14], st[15]);
#pragma unroll
            for (int db = 0; db < 4; ++db) {
#pragma unroll
                for (int rr = 0; rr < 16; ++rr) acc[db][rr] *= alpha;
                const LAS unsigned char* vrow = lds + LX_V + (32 * db + l31) * VTROW + (32 * kt + 4 * hi) * 2;
                { const s16x4 lo = *(const LAS s16x4*)(vrow), h4 = *(const LAS s16x4*)(vrow + 16);
                  bf16x8 af; af[0] = lo[0]; af[1] = lo[1]; af[2] = lo[2]; af[3] = lo[3]; af[4] = h4[0]; af[5] = h4[1]; af[6] = h4[2]; af[7] = h4[3];
                  acc[db] = MFMA32(af, p0, acc[db]); }
                { const s16x4 lo = *(const LAS s16x4*)(vrow + 32), h4 = *(const LAS s16x4*)(vrow + 48);
                  bf16x8 af; af[0] = lo[0]; af[1] = lo[1]; af[2] = lo[2]; af[3] = lo[3]; af[4] = h4[0]; af[5] = h4[1]; af[6] = h4[2]; af[7] = h4[3];
                  acc[db] = MFMA32(af, p1, acc[db]); }
            }
        }
        const float inv = 1.0f / l_run;
        bf16_t* op = co + mq * DCROSS + h * 128 + 4 * hi;
#pragma unroll
        for (int db = 0; db < 4; ++db)
#pragma unroll
            for (int rg = 0; rg < 4; ++rg) { u32x2 w; w.x = pk2(acc[db][4 * rg] * inv, acc[db][4 * rg + 1] * inv); w.y = pk2(acc[db][4 * rg + 2] * inv, acc[db][4 * rg + 3] * inv);
                *(u32x2*)(op + 32 * db + 8 * rg) = w; }
    }
}

#define XB_TMO      128
#define XB_XCNT(j)  (256  + 64 * (j))
#define XB_XSUB(j)  (1280 + 64 * (j))
#define XB_XGEN(j)  (2304 + 64 * (j))
#define XB_TOP      3328
#define XB_TOPGEN   3392
#define XCD_BAR_WORDS 3456
#define XB_SPIN_CAP (1u << 18)
__device__ __forceinline__ unsigned xb_ld(unsigned* p)              { return __hip_atomic_load(p, __ATOMIC_RELAXED, __HIP_MEMORY_SCOPE_AGENT); }
__device__ __forceinline__ unsigned xb_add(unsigned* p, unsigned v) { return __hip_atomic_fetch_add(p, v, __ATOMIC_RELAXED, __HIP_MEMORY_SCOPE_AGENT); }
__device__ __forceinline__ unsigned xb_xcc_id() { return (unsigned)__builtin_amdgcn_s_getreg((3 << 11) | 20) & 0xFu; }
#define XB_SPIN(cond, bar) do { unsigned _sp = 0; while (cond) { __builtin_amdgcn_s_sleep(1); \
    if ((++_sp & 255u) == 0u) { if (xb_ld(&(bar)[XB_TMO])) break; if (_sp > XB_SPIN_CAP) { atomicAdd(&(bar)[XB_TMO], 1u); break; } } } } while (0)
struct XcdBarrier { unsigned* bar; unsigned x; volatile LAS unsigned* st; };
__device__ __forceinline__ XcdBarrier xcd_barrier_post(unsigned* bar, volatile LAS unsigned* st) {
    XcdBarrier b; b.bar = bar; b.x = xb_xcc_id(); b.st = st;
    if (threadIdx.x == 0) (void)xb_add(&bar[XB_XCNT(b.x)], 1u);
    return b;
}
__device__ __forceinline__ void xcd_barrier_complete(unsigned* bar, unsigned x, unsigned& nloc, unsigned& nx) {
    const unsigned G = gridDim.x * gridDim.y * gridDim.z;
    unsigned sum, cnt, mine, sp = 0u;
    for (;;) {
        sum = 0u; cnt = 0u; mine = 0u;
#pragma unroll
        for (unsigned j = 0; j < 16; ++j) { const unsigned c = xb_ld(&bar[XB_XCNT(j)]); sum += c; cnt += (c > 0u) ? 1u : 0u; mine = (j == x) ? c : mine; }
        if (sum == G) break;
        __builtin_amdgcn_s_sleep(1);
        if ((++sp & 255u) == 0u) { if (xb_ld(&bar[XB_TMO])) break; if (sp > XB_SPIN_CAP) { atomicAdd(&bar[XB_TMO], 1u); break; } }
    }
    nloc = mine > 0u ? mine : 1u; nx = cnt > 0u ? cnt : 1u;
}
__device__ __forceinline__ void xcd_barrier(const XcdBarrier& b) {
    asm volatile("s_waitcnt vmcnt(0)" ::: "memory");
    __syncthreads();
    if (threadIdx.x == 0) {
        unsigned* bar = b.bar;
        __builtin_amdgcn_s_waitcnt(0);
        unsigned nloc = b.st[0], nx = b.st[1];
        if (nloc == 0u) { xcd_barrier_complete(bar, b.x, nloc, nx); b.st[0] = nloc; b.st[1] = nx; }
        const unsigned old = xb_add(&bar[XB_XSUB(b.x)], 1u);
        const unsigned gen = old / nloc;
        if (old + 1u == (gen + 1u) * nloc) {
            __builtin_amdgcn_fence(__ATOMIC_RELEASE, "agent");
            asm volatile("s_waitcnt vmcnt(0)" ::: "memory");
            const unsigned og = xb_add(&bar[XB_TOP], 1u);
            const unsigned tg = og / nx;
            if (og + 1u == (tg + 1u) * nx) xb_add(&bar[XB_TOPGEN], 1u);
            else XB_SPIN(xb_ld(&bar[XB_TOPGEN]) == tg, bar);
            __builtin_amdgcn_fence(__ATOMIC_ACQUIRE, "agent");
            xb_add(&bar[XB_XGEN(b.x)], 1u);
            asm volatile("s_waitcnt vmcnt(0)" ::: "memory");
        } else {
            XB_SPIN(xb_ld(&bar[XB_XGEN(b.x)]) == gen, bar);
            __builtin_amdgcn_fence(__ATOMIC_ACQUIRE, "agent");
            asm volatile("s_waitcnt vmcnt(0)" ::: "memory");
        }
    }
    __syncthreads();
}

__global__ void __launch_bounds__(512, 2) mega_fwd(Args a) {
    extern __shared__ __attribute__((aligned(16))) unsigned char lds_raw[];
    LAS unsigned char* lds = (LAS unsigned char*)lds_raw;
    unsigned char* ws = a.ws;
    const int G = gridDim.x, cb = blockIdx.x;
    const int lo = a.lo, hi = a.hi;
#define IN(k) (lo <= (k) && (k) < hi)
#if MK_COOP
    volatile LAS unsigned* bst = (volatile LAS unsigned*)(lds + LDS_BYTES - 64);
    if (threadIdx.x < 2) bst[threadIdx.x] = 0u;
    __syncthreads();
    XcdBarrier xbar = xcd_barrier_post((unsigned*)(ws + WS_BAR), bst);
    if (lo < 0) cg::this_grid().sync();
#define SEAM(k) do { if ((k) + 1 < hi) { xcd_barrier(xbar); } } while (0)
#else
#define SEAM(k) do { } while (0)
#endif
    if (IN(0)) { p0_prologue(a, lds); if (PROBE_DUP == 0) { __syncthreads(); p0_prologue(a, lds); } SEAM(0); }
    if (IN(1)) {
        pg8::Gemm g{(const bf16_t*)(ws + WS_XB), (const bf16_t*)(ws + WS_WIN), DM, DM, MTOK / 256, NPROJ / 256, 1, DM, G, cb};
        pg8::EpiScaleBf16<0, 0> E{(bf16_t*)(ws + WS_PROJ), NPROJ, (const float*)(ws + WS_RSTD0)};
        pg8::gemm_phase(lds, g, E); if (PROBE_DUP == 1) pg8::gemm_phase(lds, g, E); SEAM(1);
    }
    if (IN(2)) { p2_ssd_states(a, lds); if (PROBE_DUP == 2) p2_ssd_states(a, lds); p2_qkprep(a); SEAM(2); }
    if (IN(3)) {
        { pg8::Gemm g{(const bf16_t*)(ws + WS_MEMB), (const bf16_t*)(ws + WS_WCKV), DM, DM, MMEM / 256, (2 * DCROSS) / 256, 2, DM / 2, G, cb};
          pg8::EpiPart E{(float*)(ws + WS_KVPART), 2 * DCROSS, (size_t)MMEM * 2 * DCROSS};
          pg8::gemm_phase(lds, g, E); }
        p3_scan(a); p3_attn(a, lds); SEAM(3);
    }
    if (IN(4)) { p3_ssd_out(a, lds); p4_combine(a); SEAM(4); }
    if (IN(5)) {
        pg8::Gemm g{(const bf16_t*)(ws + WS_PROJ), (const bf16_t*)(ws + WS_WOUT), NPROJ, DM, MTOK / 256, DM / 256, 1, DM, G, cb};
        pg8::EpiResid<0> E{a.in[0], nullptr, nullptr, (bf16_t*)(ws + WS_X1B), (float*)(ws + WS_SUMSQ1)};
        pg8::gemm_phase(lds, g, E); SEAM(5);
    }
    if (IN(6)) {
        pg8::Gemm g{(const bf16_t*)(ws + WS_X1B), (const bf16_t*)(ws + WS_WCQ), DM, DM, MTOK / 256, DCROSS / 256, 4, DM / 4, G, cb};
        pg8::EpiPartBf16 E{(bf16_t*)(ws + WS_QPART), DCROSS, (size_t)MTOK * DCROSS};
        pg8::gemm_phase(lds, g, E);
        p5_kvprep(a); SEAM(6);
    }
    if (IN(7)) {
        p6_cross(a, lds);
        {
            const int wv = threadIdx.x >> 6, ln = threadIdx.x & 63; LAS float* scr = (LAS float*)(lds + wv * 16640);
            __syncthreads();
            int i0, i1, w0, nw;
            if (G == 256) { if (blockIdx.x >= 128) { i0 = 0; i1 = 3200; w0 = (blockIdx.x - 128) * 8 + wv; } else { i0 = 3200; i1 = 4096; w0 = blockIdx.x * 8 + wv; } nw = 1024; }
            else { i0 = 0; i1 = 4096; w0 = blockIdx.x * 8 + wv; nw = G * 8; }
            for (int it = i0 + w0; it < i1; it += nw) { int r = it; p0_mat(r, a.in[24], DFF, DM, DM, (bf16_t*)(ws + WS_WDOWN), nullptr, false, scr, ln); }
        }
        SEAM(7);
    }
    if (IN(8)) {
        pg8::Gemm g{(const bf16_t*)(ws + WS_CO), (const bf16_t*)(ws + WS_WCO), DCROSS, DCROSS, MTOK / 256, DM / 256, 1, DCROSS, G, cb};
        pg8::EpiResid<1> E{nullptr, (const bf16_t*)(ws + WS_X1B), nullptr, (bf16_t*)(ws + WS_X2B), (float*)(ws + WS_SUMSQ2)};
        pg8::gemm_phase(lds, g, E); SEAM(8);
    }
    if (IN(9)) {
        pg8::Gemm g{(const bf16_t*)(ws + WS_X2B), (const bf16_t*)(ws + WS_WUP), DM, DM, MTOK / 256, DFF / 256, 1, DM, G, cb};
        pg8::EpiScaleBf16<1, 1> E{(bf16_t*)(ws + WS_HID), DFF, (const float*)(ws + WS_SUMSQ2)};
        pg8::gemm_phase(lds, g, E); if (PROBE_DUP == 9) pg8::gemm_phase(lds, g, E); SEAM(9);
    }
    if (IN(10)) {
        pg8::Gemm g{(const bf16_t*)(ws + WS_HID), (const bf16_t*)(ws + WS_WDOWN), DFF, DFF, MTOK / 256, DM / 256, 1, DFF, G, cb};
        pg8::EpiResid<2> E{nullptr, (const bf16_t*)(ws + WS_X2B), a.out, nullptr, nullptr};
        pg8::gemm_phase(lds, g, E);
    }
#undef IN
#undef SEAM
}

extern "C" void kernel_launch(void* const* d_in, const int* in_sizes, int n_in, void* d_out, int out_size, void* d_ws, size_t ws_size, hipStream_t stream) {
    static int grid = 0;
    if (grid == 0) {
        if (n_in != 25 || out_size != MTOK * DM || ws_size < WS_END) { fprintf(stderr, "kernel_launch: unexpected problem (n_in %d, out %d, ws %zu < %zu)\n", n_in, out_size, ws_size, (size_t)WS_END); grid = -1; return; }
        int dev = 0, cus = 0, per_cu = 0;
        hipGetDevice(&dev); hipDeviceGetAttribute(&cus, hipDeviceAttributeMultiprocessorCount, dev);
        if (hipFuncSetAttribute((const void*)mega_fwd, hipFuncAttributeMaxDynamicSharedMemorySize, LDS_BYTES) != hipSuccess) { fprintf(stderr, "kernel_launch: hipFuncSetAttribute failed\n"); grid = -1; return; }
        if (hipOccupancyMaxActiveBlocksPerMultiprocessor(&per_cu, (const void*)mega_fwd, 512, LDS_BYTES) != hipSuccess || per_cu < 1) { fprintf(stderr, "kernel_launch: occupancy query says %d\n", per_cu); per_cu = 1; }
        (void)hipGetLastError();
        grid = cus;
    }
    if (grid < 0) return;
    Args a{};
    for (int i = 0; i < 25; ++i) a.in[i] = (const float*)d_in[i];
    a.out = (float*)d_out; a.ws = (unsigned char*)d_ws;
#if MK_COOP
    a.lo = 0; a.hi = NPHASE;
    if (hipMemsetAsync((char*)d_ws + WS_BAR, 0, BAR_BYTES, stream) != hipSuccess) { fprintf(stderr, "kernel_launch: memset of the barrier words failed\n"); return; }
    void* args[] = {&a};
    hipError_t e = hipLaunchCooperativeKernel((const void*)mega_fwd, dim3(grid), dim3(512), args, LDS_BYTES, stream);
    if (e != hipSuccess) fprintf(stderr, "cooperative launch failed: %s (grid %d)\n", hipGetErrorString(e), grid);
#else
    for (int ph = 0; ph < NPHASE; ++ph) {
        a.lo = ph; a.hi = ph + 1;
        hipLaunchKernelGGL(mega_fwd, dim3(grid), dim3(512), LDS_BYTES, stream, a);
    }
#endif
}
```

```cpp
#include <hip/hip_runtime.h>
#include <hip/hip_cooperative_groups.h>
#include <cstdio>
#include <cstdint>
namespace cg = cooperative_groups;

#ifndef PROBE_DUP
#define PROBE_DUP -1
#endif
#ifndef MK_COOP
#define MK_COOP 1
#endif

#define LAS __attribute__((address_space(3)))
typedef unsigned short bf16_t;
typedef short bf16x8 __attribute__((ext_vector_type(8)));
typedef short s16x4 __attribute__((ext_vector_type(4)));
typedef float f32x2 __attribute__((ext_vector_type(2)));
typedef float f32x4 __attribute__((ext_vector_type(4)));
typedef float f32x16 __attribute__((ext_vector_type(16)));
typedef unsigned u32x4 __attribute__((ext_vector_type(4)));
typedef unsigned u32x2 __attribute__((ext_vector_type(2)));

constexpr int DM = 2048, NB = 4, SEQ = 2048, MTOK = NB * SEQ;
constexpr int DIN = 6160, NPROJ = 6144;
constexpr int NMEM = 256, MMEM = NB * NMEM, DCROSS = 512, DFF = 8192;
constexpr float EPS = 1e-6f;
constexpr int PC_Q = 0, PC_Z = 1024, PC_K = 2048, PC_V = 3072, PC_X = 4096;

constexpr size_t MiB = 1u << 20;
constexpr size_t WS_WOUT = 0, WS_WCQ = 8 * MiB, WS_WCKV = 10 * MiB, WS_WCO = 14 * MiB, WS_WUP = 16 * MiB, WS_WDOWN = 48 * MiB;
constexpr size_t WS_SMALL = 80 * MiB;
constexpr size_t WS_DT = WS_SMALL, WS_RSTD0 = WS_SMALL + 512 * 1024, WS_RSTDM = WS_RSTD0 + 32 * 1024, WS_SUMSQ1 = WS_RSTDM + 4096, WS_SUMSQ2 = WS_SUMSQ1 + 32 * 1024,
                 WS_ATOT = WS_SUMSQ2 + 32 * 1024, WS_LSE = WS_SMALL + 1 * MiB, WS_MEMB = WS_SMALL + 3 * MiB, WS_KC = WS_SMALL + 7 * MiB, WS_VCT = WS_SMALL + 8 * MiB;
constexpr size_t WS_BAR = WS_SMALL + 9 * MiB, BAR_BYTES = 16384;
constexpr size_t WS_WIN = 92 * MiB, WS_XB = 116 * MiB, WS_PROJ = 148 * MiB, WS_STATES = 244 * MiB;
constexpr size_t WS_OBR = 92 * MiB, WS_X1B = 92 * MiB, WS_KVPART = 140 * MiB, WS_QPART = 148 * MiB, WS_CO = 212 * MiB, WS_X2B = 220 * MiB, WS_HID = 92 * MiB;
constexpr size_t WS_END = 276 * MiB;

constexpr int LDS_BYTES = 155648;
constexpr int NPHASE = 11;

__device__ __forceinline__ unsigned f2bf(float f) { unsigned u = __float_as_uint(f); return (u + 0x7fffu + ((u >> 16) & 1u)) >> 16; }
__device__ __forceinline__ unsigned pk2(float lo, float hi) { unsigned r; asm volatile("v_cvt_pk_bf16_f32 %0, %1, %2" : "=v"(r) : "v"(lo), "v"(hi)); return r; }
__device__ __forceinline__ float bflo(unsigned w) { return __uint_as_float(w << 16); }
__device__ __forceinline__ float bfhi(unsigned w) { return __uint_as_float(w & 0xffff0000u); }
__device__ __forceinline__ float wave_sum(float v) {
#pragma unroll
    for (int o = 1; o < 64; o <<= 1) v += __shfl_xor(v, o);
    return v;
}
__device__ __forceinline__ bf16x8 pack8(float a0, float a1, float a2, float a3, float a4, float a5, float a6, float a7) {
    u32x4 w; w.x = pk2(a0, a1); w.y = pk2(a2, a3); w.z = pk2(a4, a5); w.w = pk2(a6, a7);
    return __builtin_bit_cast(bf16x8, w);
}
#define MFMA32(a, b, c) __builtin_amdgcn_mfma_f32_32x32x16_bf16((a), (b), (c), 0, 0, 0)
__device__ __forceinline__ f32x16 zero16() { f32x16 z;
#pragma unroll
    for (int i = 0; i < 16; ++i) z[i] = 0.f; return z; }

namespace pg8 {
constexpr int BM = 256, BK = 64, HALF = 128, HTB = HALF * BK * 2, NXCD = 8, WGM = 4;
__device__ __forceinline__ int lds_byte(int r, int c) { const int st = (r >> 4) * 2 + (c >> 5), rr = r & 15, cc = c & 31, ob = rr * 64 + cc * 2; return st * 1024 + (ob ^ (((ob >> 9) & 1) << 5)); }
__device__ __forceinline__ void stage_rc(int b, int& R, int& C) { const int st = b / 1024, sb = b % 1024, swz = sb ^ (((sb >> 9) & 1) << 5); R = (st >> 1) * 16 + swz / 64; C = (st & 1) * 32 + (swz % 64) / 2; }
__device__ __forceinline__ int perm32(int rho) { const int n = rho >> 4, i = rho & 15; return 8 * (i >> 2) + 4 * n + (i & 3); }

struct Unit { int pm, pn, ks; };
struct Gemm { const bf16_t* A; const bf16_t* Bt; int lda, ldb, nM, nN, nKS, Klen, G, c; };

__device__ __forceinline__ bool next_unit(const Gemm& g, int i, Unit& u) {
    const int nwg = g.nM * g.nN; const long L = (long)i * g.G + g.c; if (L >= (long)nwg * g.nKS) return false;
    u.ks = (int)(L / nwg); int wgid = (int)(L % nwg);
    { const int q = nwg / NXCD, r = nwg % NXCD, xcd = wgid % NXCD, off = wgid / NXCD; wgid = (xcd < r ? xcd * (q + 1) : r * (q + 1) + (xcd - r) * q) + off; }
    const int nig = WGM * g.nN, gid = wgid / nig, fm = gid * WGM, gsz = (g.nM - fm) < WGM ? (g.nM - fm) : WGM;
    u.pm = fm + ((wgid % nig) % gsz); u.pn = (wgid % nig) / gsz; return true;
}

template <class Epi>
__device__ __forceinline__ void gemm_phase(LAS unsigned char* lds, const Gemm g, const Epi& E) {
    const int tid = threadIdx.x, wid = __builtin_amdgcn_readfirstlane(tid >> 6), lane = tid & 63, wr = wid >> 2, wc = wid & 3, fr = lane & 15, fq = lane >> 4;
    const int nt = g.Klen / BK;
    unsigned voffA[2], voffB[2];
#pragma unroll
    for (int i = 0; i < 2; ++i) { int R, C; stage_rc(tid * 16 + i * 8192, R, C); const int Rb = Epi::PERM ? ((R & ~31) + perm32(R & 31)) : R;
        voffA[i] = (unsigned)(R * g.lda + C) * 2u; voffB[i] = (unsigned)(Rb * g.ldb + C) * 2u; }
    const size_t kstep = (size_t)(BK * 2);
    const size_t hstepA = (size_t)HALF * g.lda * 2, hstepB = (size_t)HALF * g.ldb * 2;
    const size_t tstepA = 2 * hstepA, tstepB = 2 * hstepB;
    const size_t ksoff = (size_t)g.Klen * 2;
    const unsigned ldsw = (unsigned)wid * 1024u;
    const int aoff = lds_byte(wr * 64 + fr, fq * 8), boff = lds_byte(wc * 32 + fr, fq * 8);
#define PG8_SA(b, h) (((b) * 2 + (h)) * HTB)
#define PG8_SB(b, h) ((4 + (b) * 2 + (h)) * HTB)
#define PG8_STAGE(bufoff, gbase, voff) do { _Pragma("unroll") for (int _i = 0; _i < 2; ++_i) \
        __builtin_amdgcn_global_load_lds((const unsigned*)((const char*)(gbase) + (voff)[_i]), (LAS unsigned*)(lds + (bufoff) + ldsw + _i * 8192), 16, 0, 0); } while (0)
#define PG8_LDA(dst, b, h) do { _Pragma("unroll") for (int m = 0; m < 4; ++m) _Pragma("unroll") for (int k = 0; k < 2; ++k) dst[m][k] = *(const LAS bf16x8*)(lds + PG8_SA(b, h) + aoff + m * 2048 + k * 1024); } while (0)
#define PG8_LDB(dst, b, h) do { _Pragma("unroll") for (int n = 0; n < 2; ++n) _Pragma("unroll") for (int k = 0; k < 2; ++k) dst[n][k] = *(const LAS bf16x8*)(lds + PG8_SB(b, h) + boff + n * 2048 + k * 1024); } while (0)
#define PG8_MMA(ai, bj, At, Bt) do { __builtin_amdgcn_s_setprio(1); _Pragma("unroll") for (int m = 0; m < 4; ++m) _Pragma("unroll") for (int n = 0; n < 2; ++n) _Pragma("unroll") for (int k = 0; k < 2; ++k) \
        acc[ai][bj][m][n] = __builtin_amdgcn_mfma_f32_16x16x32_bf16(Bt[n][k], At[m][k], acc[ai][bj][m][n], 0, 0, 0); __builtin_amdgcn_s_setprio(0); } while (0)
#define PG8_WAIT_V(n) asm volatile("s_waitcnt vmcnt(" #n ")" ::: "memory")
#define PG8_WAIT_L(n) asm volatile("s_waitcnt lgkmcnt(" #n ")" ::: "memory")
#define PG8_BAR __builtin_amdgcn_s_barrier()
#define PG8_SCHED __builtin_amdgcn_sched_barrier(0)
    Unit cur, nxt; int ui = 0;
    if (!next_unit(g, 0, cur)) return;
    f32x4 acc[2][2][4][2];
#pragma unroll
    for (int a = 0; a < 2; ++a)
#pragma unroll
        for (int b = 0; b < 2; ++b)
#pragma unroll
            for (int m = 0; m < 4; ++m)
#pragma unroll
                for (int n = 0; n < 2; ++n) acc[a][b][m][n] = (f32x4){0.f, 0.f, 0.f, 0.f};
    bf16x8 At[4][2], B0[2][2], B1[2][2];
    const char* cA = (const char*)g.A + (size_t)cur.pm * tstepA + (size_t)cur.ks * ksoff; const char* cB = (const char*)g.Bt + (size_t)cur.pn * tstepB + (size_t)cur.ks * ksoff;
    PG8_STAGE(PG8_SB(0, 0), cB, voffB); PG8_STAGE(PG8_SB(0, 1), cB + hstepB, voffB); PG8_STAGE(PG8_SA(0, 0), cA, voffA); PG8_STAGE(PG8_SA(0, 1), cA + hstepA, voffA);
    if (wr == 1) PG8_BAR;
    PG8_WAIT_V(2); PG8_BAR;
    PG8_STAGE(PG8_SB(1, 0), cB + kstep, voffB); PG8_STAGE(PG8_SA(1, 0), cA + kstep, voffA); PG8_STAGE(PG8_SB(1, 1), cB + hstepB + kstep, voffB);
    PG8_WAIT_V(6); PG8_BAR;
    for (;;) {
        const bool has_next = next_unit(g, ui + 1, nxt);
        const char* nA = has_next ? (const char*)g.A + (size_t)nxt.pm * tstepA + (size_t)nxt.ks * ksoff : cA;
        const char* nB = has_next ? (const char*)g.Bt + (size_t)nxt.pn * tstepB + (size_t)nxt.ks * ksoff : cB;
        for (int t = 0; t < nt; t += 2) {
            const bool last = (t == nt - 2);
            const char* a1 = cA + (size_t)(t + 1) * kstep;
            const char* a2 = last ? nA : cA + (size_t)(t + 2) * kstep; const char* b2 = last ? nB : cB + (size_t)(t + 2) * kstep;
            const char* a3 = a2 + kstep; const char* b3 = b2 + kstep;
            PG8_LDB(B0, 0, 0); PG8_LDB(B1, 0, 1); PG8_SCHED; PG8_LDA(At, 0, 0); PG8_STAGE(PG8_SA(1, 1), a1 + hstepA, voffA);
            PG8_WAIT_V(8); PG8_WAIT_L(0); PG8_BAR; PG8_MMA(0, 0, At, B0); PG8_MMA(0, 1, At, B1); PG8_BAR; PG8_SCHED;
            PG8_LDA(At, 0, 1); PG8_STAGE(PG8_SB(0, 0), b2, voffB); PG8_STAGE(PG8_SB(0, 1), b2 + hstepB, voffB); PG8_STAGE(PG8_SA(0, 0), a2, voffA);
            PG8_WAIT_V(8); PG8_WAIT_L(0); PG8_BAR; PG8_MMA(1, 0, At, B0); PG8_MMA(1, 1, At, B1); PG8_BAR; PG8_SCHED;
            PG8_LDB(B0, 1, 0); PG8_LDB(B1, 1, 1); PG8_SCHED; PG8_LDA(At, 1, 0); PG8_STAGE(PG8_SA(0, 1), a2 + hstepA, voffA);
            PG8_WAIT_V(8); PG8_WAIT_L(0); PG8_BAR; PG8_MMA(0, 0, At, B0); PG8_MMA(0, 1, At, B1); PG8_BAR; PG8_SCHED;
            PG8_LDA(At, 1, 1); PG8_STAGE(PG8_SB(1, 0), b3, voffB); PG8_STAGE(PG8_SB(1, 1), b3 + hstepB, voffB); PG8_STAGE(PG8_SA(1, 0), a3, voffA);
            PG8_WAIT_V(8); PG8_WAIT_L(0); PG8_BAR; PG8_MMA(1, 0, At, B0); PG8_MMA(1, 1, At, B1); PG8_BAR; PG8_SCHED;
        }
        if (wr == 0) PG8_BAR;
        E(acc, cur, wr, wc, fr, fq);
        if (!has_next) break;
#pragma unroll
        for (int a = 0; a < 2; ++a)
#pragma unroll
            for (int b = 0; b < 2; ++b)
#pragma unroll
                for (int m = 0; m < 4; ++m)
#pragma unroll
                    for (int n = 0; n < 2; ++n) acc[a][b][m][n] = (f32x4){0.f, 0.f, 0.f, 0.f};
        cur = nxt; cA = nA; cB = nB; ++ui;
        if (wr == 1) PG8_BAR;
    }
    PG8_WAIT_V(0);
    PG8_BAR;
#undef PG8_SA
#undef PG8_SB
#undef PG8_STAGE
#undef PG8_LDA
#undef PG8_LDB
#undef PG8_MMA
#undef PG8_WAIT_V
#undef PG8_WAIT_L
#undef PG8_BAR
#undef PG8_SCHED
}

template <int MODE, int ACT> struct EpiScaleBf16 {
    static constexpr bool PERM = true;
    bf16_t* O; int ldc; const float* rs;
    __device__ __forceinline__ void operator()(const f32x4 (&acc)[2][2][4][2], const Unit& u, int wr, int wc, int fr, int fq) const {
        const int row0 = u.pm * BM + wr * 64 + fr, col0 = u.pn * BM + wc * 32 + 8 * fq;
#pragma unroll
        for (int ai = 0; ai < 2; ++ai)
#pragma unroll
            for (int m = 0; m < 4; ++m) {
                const int row = row0 + ai * HALF + m * 16;
                float s = rs[row]; if (MODE == 1) s = rsqrtf(s * (1.0f / 2048.0f) + EPS);
                bf16_t* rowp = O + (size_t)row * ldc + col0;
#pragma unroll
                for (int bj = 0; bj < 2; ++bj) {
                    f32x4 v0 = acc[ai][bj][m][0] * s, v1 = acc[ai][bj][m][1] * s;
                    if (ACT == 1) {
#pragma unroll
                        for (int e = 0; e < 4; ++e) { float a = fmaxf(v0[e], 0.f), b = fmaxf(v1[e], 0.f); v0[e] = a * a; v1[e] = b * b; }
                    }
                    u32x4 w; w.x = pk2(v0[0], v0[1]); w.y = pk2(v0[2], v0[3]); w.z = pk2(v1[0], v1[1]); w.w = pk2(v1[2], v1[3]);
                    *(u32x4*)(rowp + bj * HALF) = w;
                }
            }
    }
};
template <int MODE> struct EpiResid {
    static constexpr bool PERM = false;
    const float* basef; const bf16_t* baseb; float* out; bf16_t* outb; float* sumsq;
    __device__ __forceinline__ void operator()(const f32x4 (&acc)[2][2][4][2], const Unit& u, int wr, int wc, int fr, int fq) const {
        const int row0 = u.pm * BM + wr * 64 + fr, col0 = u.pn * BM + wc * 32 + 4 * fq;
#pragma unroll
        for (int ai = 0; ai < 2; ++ai)
#pragma unroll
            for (int m = 0; m < 4; ++m) {
                const int row = row0 + ai * HALF + m * 16; const size_t off = (size_t)row * DM + col0; float ss = 0.f;
#pragma unroll
                for (int bj = 0; bj < 2; ++bj)
#pragma unroll
                    for (int n = 0; n < 2; ++n) {
                        f32x4 bs;
                        if (MODE == 0) bs = *(const f32x4*)(basef + off + bj * HALF + n * 16);
                        else { const u32x2 bw = *(const u32x2*)(baseb + off + bj * HALF + n * 16); bs = (f32x4){bflo(bw.x), bfhi(bw.x), bflo(bw.y), bfhi(bw.y)}; }
                        const f32x4 o = bs + acc[ai][bj][m][n];
                        if (MODE == 2) *(f32x4*)(out + off + bj * HALF + n * 16) = o;
                        else { u32x2 w; w.x = pk2(o[0], o[1]); w.y = pk2(o[2], o[3]); *(u32x2*)(outb + off + bj * HALF + n * 16) = w;
                            ss += (o[0] * o[0] + o[1] * o[1]) + (o[2] * o[2] + o[3] * o[3]); }
                    }
                if (MODE != 2) { ss += __shfl_xor(ss, 16); ss += __shfl_xor(ss, 32); if (fq == 0) atomicAdd(sumsq + row, ss); }
            }
    }
};
struct EpiPart {
    static constexpr bool PERM = false;
    float* part; int ldc; size_t ks_stride;
    __device__ __forceinline__ void operator()(const f32x4 (&acc)[2][2][4][2], const Unit& u, int wr, int wc, int fr, int fq) const {
        const int row0 = u.pm * BM + wr * 64 + fr, col0 = u.pn * BM + wc * 32 + 4 * fq; float* pb = part + (size_t)u.ks * ks_stride;
#pragma unroll
        for (int ai = 0; ai < 2; ++ai)
#pragma unroll
            for (int m = 0; m < 4; ++m) { const size_t off = (size_t)(row0 + ai * HALF + m * 16) * ldc + col0;
#pragma unroll
                for (int bj = 0; bj < 2; ++bj)
#pragma unroll
                    for (int n = 0; n < 2; ++n) *(f32x4*)(pb + off + bj * HALF + n * 16) = acc[ai][bj][m][n]; }
    }
};
struct EpiPartBf16 {
    static constexpr bool PERM = true;
    bf16_t* part; int ldc; size_t ks_stride;
    __device__ __forceinline__ void operator()(const f32x4 (&acc)[2][2][4][2], const Unit& u, int wr, int wc, int fr, int fq) const {
        const int row0 = u.pm * BM + wr * 64 + fr, col0 = u.pn * BM + wc * 32 + 8 * fq; bf16_t* pb = part + (size_t)u.ks * ks_stride;
#pragma unroll
        for (int ai = 0; ai < 2; ++ai)
#pragma unroll
            for (int m = 0; m < 4; ++m) { bf16_t* rowp = pb + (size_t)(row0 + ai * HALF + m * 16) * ldc + col0;
#pragma unroll
                for (int bj = 0; bj < 2; ++bj) { const f32x4 v0 = acc[ai][bj][m][0], v1 = acc[ai][bj][m][1];
                    u32x4 w; w.x = pk2(v0[0], v0[1]); w.y = pk2(v0[2], v0[3]); w.z = pk2(v1[0], v1[1]); w.w = pk2(v1[2], v1[3]); *(u32x4*)(rowp + bj * HALF) = w; } }
    }
};
}

struct Args {
    const float* in[25]; float* out; unsigned char* ws; int lo, hi;
};

__device__ __forceinline__ void p0_transpose_item(const float* __restrict__ W, int K, int N, bf16_t* __restrict__ WT, const float* __restrict__ gain, LAS float* scr, int k0, int n0, int drow0, int lane) {
    f32x4 v[16]; const int kr = lane >> 4, n4 = (lane & 15) * 4;
#pragma unroll
    for (int i = 0; i < 16; ++i) v[i] = __builtin_nontemporal_load((const f32x4*)(W + (size_t)(k0 + 4 * i + kr) * N + n0 + n4));
#pragma unroll
    for (int i = 0; i < 16; ++i) { const int kk = 4 * i + kr; const float g = gain ? gain[k0 + kk] : 1.0f; LAS float* d = scr + kk * 65 + n4;
        d[0] = v[i][0] * g; d[1] = v[i][1] * g; d[2] = v[i][2] * g; d[3] = v[i][3] * g; }
    asm volatile("s_waitcnt lgkmcnt(0)" ::: "memory");
    const int c = lane & 7;
#pragma unroll
    for (int j = 0; j < 8; ++j) { const int n = (lane >> 3) + 8 * j; const LAS float* s = scr + (8 * c) * 65 + n;
        u32x4 o; o.x = pk2(s[0 * 65], s[1 * 65]); o.y = pk2(s[2 * 65], s[3 * 65]); o.z = pk2(s[4 * 65], s[5 * 65]); o.w = pk2(s[6 * 65], s[7 * 65]);
        *(u32x4*)(WT + (size_t)(drow0 + n) * K + k0 + 8 * c) = o; }
    asm volatile("s_waitcnt lgkmcnt(0)" ::: "memory");
}
__device__ __forceinline__ bool p0_mat(int& r, const float* W, int K, int N, int ncols, bf16_t* WT, const float* gain, bool win_map, LAS float* scr, int lane) {
    const int nblk = ncols / 64, items = (K / 64) * nblk;
    if (r >= items) { r -= items; return false; }
    const int kb = r / nblk, nb = r % nblk, n0 = 64 * nb; int drow0 = n0;
    if (win_map) { const int seg = n0 >> 10; const int dseg = (seg == 1) ? 2 : (seg == 2) ? 3 : (seg == 3) ? 1 : seg; drow0 = dseg * 1024 + (n0 & 1023); }
    p0_transpose_item(W, K, N, WT, gain, scr, 64 * kb, n0, drow0, lane);
    return true;
}
__device__ __forceinline__ void p0_prologue(const Args& a, LAS unsigned char* lds) {
    const int tid = threadIdx.x, lane = tid & 63, wave = tid >> 6, G = gridDim.x;
    const int gw = blockIdx.x * 8 + wave, NGW = G * 8;
    unsigned char* ws = a.ws;
    LAS float* scr = (LAS float*)(lds + wave * 16640);
    constexpr int I_IN = 32 * 96, I_OUT = 32 * 32, I_CQ = 32 * 8, I_CKV = 32 * 16, I_CO = 8 * 32, I_UP = 32 * 128, I_DN = 128 * 32;
    constexpr int NITEMS = I_IN + I_OUT + I_CQ + I_CKV + I_CO + I_UP;
    for (int it = gw; it < NITEMS; it += NGW) {
        int r = it;
        if (p0_mat(r, a.in[4], DM, DIN, NPROJ, (bf16_t*)(ws + WS_WIN), a.in[3], true, scr, lane)) continue;
        if (p0_mat(r, a.in[14], DM, DM, DM, (bf16_t*)(ws + WS_WOUT), nullptr, false, scr, lane)) continue;
        if (p0_mat(r, a.in[17], DM, DCROSS, DCROSS, (bf16_t*)(ws + WS_WCQ), a.in[15], false, scr, lane)) continue;
        if (p0_mat(r, a.in[18], DM, 2 * DCROSS, 2 * DCROSS, (bf16_t*)(ws + WS_WCKV), a.in[16], false, scr, lane)) continue;
        if (p0_mat(r, a.in[21], DCROSS, DM, DM, (bf16_t*)(ws + WS_WCO), nullptr, false, scr, lane)) continue;
        p0_mat(r, a.in[23], DM, DFF, DFF, (bf16_t*)(ws + WS_WUP), a.in[22], false, scr, lane);
    }
    { float* z = (float*)(ws + WS_SUMSQ1); for (int i = blockIdx.x * 512 + tid; i < 2 * MTOK; i += G * 512) z[i] = 0.f; }
    __syncthreads();
    LAS float* wdt = (LAS float*)lds;
    { const float* win = a.in[4]; const float* gm = a.in[3];
      for (int k = tid; k < DM; k += 512) { const int i = k >> 8, l = (k & 255) >> 2, c = k & 3, s = (4 * i + c) * 64 + l; const float g = gm[k];
#pragma unroll
          for (int jc = 0; jc < 4; ++jc) { f32x4 w = *(const f32x4*)(win + (size_t)k * DIN + NPROJ + 4 * jc); w = w * g; *(LAS f32x4*)(wdt + s * 16 + 4 * (jc ^ ((l >> 2) & 3))) = w; } } }
    __syncthreads();
    const float* x = a.in[0]; const float* dtb = a.in[10];
    bf16_t* xb = (bf16_t*)(ws + WS_XB); float* rstd0 = (float*)(ws + WS_RSTD0); float* dtv = (float*)(ws + WS_DT);
    for (int row = gw; row < MTOK; row += NGW) {
        const f32x4* xr = (const f32x4*)(x + (size_t)row * DM) + lane;
        f32x4 v[8]; float ss = 0.f;
#pragma unroll
        for (int i = 0; i < 8; ++i) { v[i] = __builtin_nontemporal_load(xr + 64 * i); ss += (v[i][0] * v[i][0] + v[i][1] * v[i][1]) + (v[i][2] * v[i][2] + v[i][3] * v[i][3]); }
        ss = wave_sum(ss); const float rstd = rsqrtf(ss * (1.0f / DM) + EPS);
        u32x2* o8 = (u32x2*)(xb + (size_t)row * DM) + lane;
#pragma unroll
        for (int i = 0; i < 8; ++i) { u32x2 w; w.x = pk2(v[i][0], v[i][1]); w.y = pk2(v[i][2], v[i][3]); o8[64 * i] = w; }
        float acc[16];
#pragma unroll
        for (int j = 0; j < 16; ++j) acc[j] = 0.f;
#pragma unroll
        for (int i = 0; i < 8; ++i)
#pragma unroll
            for (int c = 0; c < 4; ++c) { const LAS float* wp = wdt + ((4 * i + c) * 64 + lane) * 16; const float xv = v[i][c];
#pragma unroll
                for (int jc = 0; jc < 4; ++jc) { const f32x4 w = *(const LAS f32x4*)(wp + 4 * (jc ^ ((lane >> 2) & 3)));
                    acc[4 * jc + 0] += xv * w[0]; acc[4 * jc + 1] += xv * w[1]; acc[4 * jc + 2] += xv * w[2]; acc[4 * jc + 3] += xv * w[3]; } }
        float a8[8], a4[4], a2[2], a1;
#pragma unroll
        for (int j = 0; j < 8; ++j) { const bool up = (lane & 32) != 0; const float mn = up ? acc[j + 8] : acc[j], ot = up ? acc[j] : acc[j + 8]; a8[j] = mn + __shfl_xor(ot, 32); }
#pragma unroll
        for (int j = 0; j < 4; ++j) { const bool up = (lane & 16) != 0; const float mn = up ? a8[j + 4] : a8[j], ot = up ? a8[j] : a8[j + 4]; a4[j] = mn + __shfl_xor(ot, 16); }
#pragma unroll
        for (int j = 0; j < 2; ++j) { const bool up = (lane & 8) != 0; const float mn = up ? a4[j + 2] : a4[j], ot = up ? a4[j] : a4[j + 2]; a2[j] = mn + __shfl_xor(ot, 8); }
        { const bool up = (lane & 4) != 0; const float mn = up ? a2[1] : a2[0], ot = up ? a2[0] : a2[1]; a1 = mn + __shfl_xor(ot, 4); }
        a1 += __shfl_xor(a1, 2); a1 += __shfl_xor(a1, 1);
        if ((lane & 3) == 0) { const int j = lane >> 2; const float xr2 = rstd * a1 + dtb[j]; dtv[(size_t)row * 16 + j] = (xr2 > 20.f) ? xr2 : log1pf(expf(xr2)); }
        if (lane == 0) rstd0[row] = rstd;
    }
    const float* mem = a.in[1]; bf16_t* memb = (bf16_t*)(ws + WS_MEMB); float* rstdm = (float*)(ws + WS_RSTDM);
    for (int row = gw; row < MMEM; row += NGW) {
        const f32x4* xr = (const f32x4*)(mem + (size_t)row * DM) + lane;
        f32x4 v[8]; float ss = 0.f;
#pragma unroll
        for (int i = 0; i < 8; ++i) { v[i] = __builtin_nontemporal_load(xr + 64 * i); ss += (v[i][0] * v[i][0] + v[i][1] * v[i][1]) + (v[i][2] * v[i][2] + v[i][3] * v[i][3]); }
        ss = wave_sum(ss);
        u32x2* o8 = (u32x2*)(memb + (size_t)row * DM) + lane;
#pragma unroll
        for (int i = 0; i < 8; ++i) { u32x2 w; w.x = pk2(v[i][0], v[i][1]); w.y = pk2(v[i][2], v[i][3]); o8[64 * i] = w; }
        if (lane == 0) rstdm[row] = rsqrtf(ss * (1.0f / DM) + EPS);
    }
}

__device__ __forceinline__ void p2_qkprep(const Args& a) {
    bf16_t* proj = (bf16_t*)(a.ws + WS_PROJ); const int* pos = (const int*)a.in[2];
    const int gl = blockIdx.x * 512 + threadIdx.x, sub = gl & 7, NIT = (gridDim.x * 512) >> 3;
    float invf[8];
#pragma unroll
    for (int j = 0; j < 8; ++j) invf[j] = __expf(-(float)j * 0.125f * 13.122363377404328f);
    for (int item0 = gl >> 3; item0 < 2 * MTOK * 16; item0 += 4 * NIT) {
        u32x4 w[4]; bf16_t* p[4]; int mm[4], wh[4];
#pragma unroll
        for (int q = 0; q < 4; ++q) { int item = item0 + q * NIT; if (item >= 2 * MTOK * 16) item = item0;
            const int h = item & 15; mm[q] = (item >> 4) & (MTOK - 1); wh[q] = item >> 17;
            p[q] = proj + (size_t)mm[q] * NPROJ + (wh[q] ? PC_K : PC_Q) + h * 64 + 8 * sub; w[q] = *(const u32x4*)p[q]; }
#pragma unroll
        for (int q = 0; q < 4; ++q) {
            const float* gn = (wh[q] ? a.in[6] : a.in[5]) + 8 * sub;
            float v[8] = {bflo(w[q].x), bfhi(w[q].x), bflo(w[q].y), bfhi(w[q].y), bflo(w[q].z), bfhi(w[q].z), bflo(w[q].w), bfhi(w[q].w)};
            float ss = 0.f;
#pragma unroll
            for (int j = 0; j < 8; ++j) ss += v[j] * v[j];
            ss += __shfl_xor(ss, 1); ss += __shfl_xor(ss, 2); ss += __shfl_xor(ss, 4);
            const float rstd = rsqrtf(ss * (1.0f / 64.0f) + EPS);
            const f32x4 g0 = *(const f32x4*)gn, g1 = *(const f32x4*)(gn + 4);
            v[0] *= rstd * g0[0]; v[1] *= rstd * g0[1]; v[2] *= rstd * g0[2]; v[3] *= rstd * g0[3]; v[4] *= rstd * g1[0]; v[5] *= rstd * g1[1]; v[6] *= rstd * g1[2]; v[7] *= rstd * g1[3];
            const float fp = (float)pos[mm[q]];
#pragma unroll
            for (int j = 0; j < 8; ++j) {
                const float other = __shfl_xor(v[j], 1);
                if (sub < 2) {
                    const float ang = fp * invf[j]; const float n = rintf(ang * 0.15915494309189535f);
                    float r = fmaf(-n, 6.2831854820251465f, ang); r = fmaf(-n, -1.7484555e-7f, r);
                    const float sn = __sinf(r), cs = __cosf(r);
                    v[j] = (sub == 0) ? (v[j] * cs - other * sn) : (v[j] * cs + other * sn);
                }
            }
            const float sc = wh[q] ? 1.0f : 0.125f;
            u32x4 o; o.x = pk2(v[0] * sc, v[1] * sc); o.y = pk2(v[2] * sc, v[3] * sc); o.z = pk2(v[4] * sc, v[5] * sc); o.w = pk2(v[6] * sc, v[7] * sc);
            if (item0 + q * NIT < 2 * MTOK * 16) *(u32x4*)p[q] = o;
        }
    }
}

constexpr int SROW = 272;
constexpr int L_XT = 0, L_B = 69632, L_C = 104448, L_F32 = 139264, L_RED = L_F32 + 6144;
__device__ __forceinline__ void ssd_dt(LAS float* f32a, const float* dtbuf, const float* a_log, int m0, int g) {
    const int tid = threadIdx.x, hh = tid >> 7, t = tid & 127;
    LAS float* dA = f32a; LAS float* acs = f32a + 512; LAS float* dtv = f32a + 1024;
    const float dt = dtbuf[(size_t)(m0 + t) * 16 + g * 4 + hh];
    const float av = -__expf(a_log[g * 4 + hh]);
    dtv[hh * 128 + t] = dt; dA[hh * 128 + t] = dt * av;
    __syncthreads();
    const int seg = t >> 4;
    float s = 0.f;
    for (int u = 16 * seg; u <= t; ++u) s += dA[hh * 128 + u];
    acs[hh * 128 + t] = s;
    __syncthreads();
    float add = 0.f;
    for (int k = 0; k < seg; ++k) add += acs[hh * 128 + 16 * k + 15];
    __syncthreads();
    acs[hh * 128 + t] = s + add;
    __syncthreads();
}
__device__ __forceinline__ int swz(int row) { return ((row >> 3) & 15) << 3; }
template <int MODE>
__device__ __forceinline__ void ssd_build(LAS unsigned char* lds, const bf16_t* proj, const float* conv_w, const float* conv_b, int c, int m0, int g, const LAS float* wgt) {
    const int tid = threadIdx.x, ch = tid & 63, s0 = (tid >> 6) * 16;
    if (MODE == 0 && ch >= 48) return;
    const int cb = (ch < 32) ? (g * 256 + ch * 8) : (ch < 48) ? (1024 + g * 128 + (ch - 32) * 8) : (1536 + g * 128 + (ch - 48) * 8);
    f32x2 cw2[4][4], bias2[4];
#pragma unroll
    for (int w = 0; w < 4; ++w) { const f32x4 w0 = *(const f32x4*)(conv_w + w * 2048 + cb), w1 = *(const f32x4*)(conv_w + w * 2048 + cb + 4);
        cw2[w][0] = (f32x2){w0[0], w0[1]}; cw2[w][1] = (f32x2){w0[2], w0[3]}; cw2[w][2] = (f32x2){w1[0], w1[1]}; cw2[w][3] = (f32x2){w1[2], w1[3]}; }
    { const f32x4 b0 = *(const f32x4*)(conv_b + cb), b1 = *(const f32x4*)(conv_b + cb + 4);
      bias2[0] = (f32x2){b0[0], b0[1]}; bias2[1] = (f32x2){b0[2], b0[3]}; bias2[2] = (f32x2){b1[0], b1[1]}; bias2[3] = (f32x2){b1[2], b1[3]}; }
#pragma unroll 1
    for (int half = 0; half < 2; ++half) {
        const int sh = s0 + 8 * half;
        const bf16_t* src = proj + (size_t)(m0 + sh) * NPROJ + PC_X + cb;
        u32x4 raw[11];
#pragma unroll
        for (int i = 0; i < 11; ++i) { const int tpos = c * 128 + sh - 3 + i; raw[i] = (tpos >= 0) ? *(const u32x4*)(src + (ptrdiff_t)(i - 3) * NPROJ) : (u32x4){0u, 0u, 0u, 0u}; }
        f32x2 win2[4][4];
#pragma unroll
        for (int i = 0; i < 3; ++i) { win2[i][0] = (f32x2){bflo(raw[i].x), bfhi(raw[i].x)}; win2[i][1] = (f32x2){bflo(raw[i].y), bfhi(raw[i].y)};
            win2[i][2] = (f32x2){bflo(raw[i].z), bfhi(raw[i].z)}; win2[i][3] = (f32x2){bflo(raw[i].w), bfhi(raw[i].w)}; }
#pragma unroll
        for (int t = 0; t < 8; ++t) {
            const int s = sh + t; const int cur = (t + 3) & 3;
            win2[cur][0] = (f32x2){bflo(raw[t + 3].x), bfhi(raw[t + 3].x)}; win2[cur][1] = (f32x2){bflo(raw[t + 3].y), bfhi(raw[t + 3].y)};
            win2[cur][2] = (f32x2){bflo(raw[t + 3].z), bfhi(raw[t + 3].z)}; win2[cur][3] = (f32x2){bflo(raw[t + 3].w), bfhi(raw[t + 3].w)};
            float acc[8];
#pragma unroll
            for (int i = 0; i < 4; ++i) { f32x2 v = bias2[i];
#pragma unroll
                for (int w = 0; w < 4; ++w) v = cw2[w][i] * win2[(t + w) & 3][i] + v;
                const f32x2 ng = v * (-1.4426950408889634f); f32x2 d; d.x = __builtin_amdgcn_exp2f(ng.x); d.y = __builtin_amdgcn_exp2f(ng.y); d = d + 1.0f;
                f32x2 rc; rc.x = __builtin_amdgcn_rcpf(d.x); rc.y = __builtin_amdgcn_rcpf(d.y); const f32x2 o = v * rc;
                acc[2 * i] = o.x; acc[2 * i + 1] = o.y; }
            if (ch < 32) {
                const int hh = ch >> 3; float sc = 1.0f; if (MODE == 0) sc = wgt[hh * 128 + s];
                const int col = s ^ swz(ch * 8);
#pragma unroll
                for (int e = 0; e < 8; e += 2) { const unsigned w = pk2(acc[e] * sc, acc[e + 1] * sc);
                    *(LAS unsigned short*)(lds + L_XT + (ch * 8 + e) * SROW + col * 2) = (unsigned short)(w & 0xffffu);
                    *(LAS unsigned short*)(lds + L_XT + (ch * 8 + e + 1) * SROW + col * 2) = (unsigned short)(w >> 16); }
            } else if (MODE == 0) {
                const int col = s ^ swz((ch - 32) * 8);
#pragma unroll
                for (int e = 0; e < 8; e += 2) { const unsigned w = pk2(acc[e], acc[e + 1]);
                    *(LAS unsigned short*)(lds + L_B + ((ch - 32) * 8 + e) * SROW + col * 2) = (unsigned short)(w & 0xffffu);
                    *(LAS unsigned short*)(lds + L_B + ((ch - 32) * 8 + e + 1) * SROW + col * 2) = (unsigned short)(w >> 16); }
            } else {
                u32x4 w; w.x = pk2(acc[0], acc[1]); w.y = pk2(acc[2], acc[3]); w.z = pk2(acc[4], acc[5]); w.w = pk2(acc[6], acc[7]);
                const int off = (ch < 48) ? (L_B + s * SROW + (ch - 32) * 16) : (L_C + s * SROW + (ch - 48) * 16);
                *(LAS u32x4*)(lds + off) = w;
            }
        }
    }
}

__device__ __forceinline__ void p2_ssd_states(const Args& a, LAS unsigned char* lds) {
    const int tid = threadIdx.x, lane = tid & 63, wid = tid >> 6, l31 = lane & 31, hi = lane >> 5;
    const bf16_t* proj = (const bf16_t*)(a.ws + WS_PROJ); const float* dtbuf = (const float*)(a.ws + WS_DT);
    float* states = (float*)(a.ws + WS_STATES); float* atot = (float*)(a.ws + WS_ATOT);
    LAS float* f32a = (LAS float*)(lds + L_C);
    for (int unit = blockIdx.x; unit < 256; unit += gridDim.x) {
        const int g = unit & 3, c = (unit >> 2) & 15, b = unit >> 6, m0 = b * SEQ + c * 128;
        __syncthreads();
        ssd_dt(f32a, dtbuf, a.in[11], m0, g);
        { const int hh = tid >> 7, t = tid & 127; const float at = f32a[512 + hh * 128 + 127];
          f32a[1536 + hh * 128 + t] = __expf(at - f32a[512 + hh * 128 + t]) * f32a[1024 + hh * 128 + t];
          if (t == 127) atot[(b * 16 + c) * 16 + g * 4 + hh] = at; }
        __syncthreads();
        ssd_build<0>(lds, proj, a.in[8], a.in[9], c, m0, g, f32a + 1536);
        __syncthreads();
        const int hh = wid >> 1, pb = wid & 1;
        f32x16 acc[4];
#pragma unroll
        for (int nb = 0; nb < 4; ++nb) acc[nb] = zero16();
#pragma unroll
        for (int ks = 0; ks < 8; ++ks) {
            const bf16x8 af = *(const LAS bf16x8*)(lds + L_XT + (hh * 64 + 32 * pb + l31) * SROW + ((16 * ks + 8 * hi) ^ swz(hh * 64 + 32 * pb + l31)) * 2);
#pragma unroll
            for (int nb = 0; nb < 4; ++nb) { const bf16x8 bf = *(const LAS bf16x8*)(lds + L_B + (32 * nb + l31) * SROW + ((16 * ks + 8 * hi) ^ swz(32 * nb + l31)) * 2); acc[nb] = MFMA32(af, bf, acc[nb]); }
        }
        float* st = states + (size_t)((b * 16 + c) * 16 + g * 4 + hh) * 8192;
#pragma unroll
        for (int nb = 0; nb < 4; ++nb)
#pragma unroll
            for (int r = 0; r < 16; ++r) { const int p = 32 * pb + (r & 3) + 8 * (r >> 2) + 4 * hi; st[p * 128 + 32 * nb + l31] = acc[nb][r]; }
    }
}

__device__ __forceinline__ void p3_scan(const Args& a) {
    const int tid = threadIdx.x, lane = tid & 63, wid = tid >> 6;
    const float* states = (const float*)(a.ws + WS_STATES); const float* atot = (const float*)(a.ws + WS_ATOT); bf16_t* prevb = (bf16_t*)a.out;
    const int gw = blockIdx.x * 8 + wid, NGW = gridDim.x * 8;
    for (int it = gw; it < 2048; it += NGW) {
        const int b = it >> 9, head = (it >> 5) & 15, prp = it & 31; const size_t eoff = (size_t)prp * 256 + lane * 4;
        f32x4 s[16]; float dec[16];
#pragma unroll
        for (int c = 0; c < 16; ++c) { s[c] = *(const f32x4*)(states + (size_t)((b * 16 + c) * 16 + head) * 8192 + eoff); dec[c] = __expf(atot[(b * 16 + c) * 16 + head]); }
        f32x4 h = (f32x4){0.f, 0.f, 0.f, 0.f};
#pragma unroll
        for (int c = 0; c < 16; ++c) { u32x2 w; w.x = pk2(h[0], h[1]); w.y = pk2(h[2], h[3]);
            *(u32x2*)(prevb + (size_t)((b * 16 + c) * 16 + head) * 8192 + eoff) = w; h = h * dec[c] + s[c]; }
    }
}

__device__ __forceinline__ void p3_ssd_out(const Args& a, LAS unsigned char* lds) {
    const int tid = threadIdx.x, lane = tid & 63, wid = tid >> 6, l31 = lane & 31, hi = lane >> 5;
    bf16_t* proj = (bf16_t*)(a.ws + WS_PROJ); const float* dtbuf = (const float*)(a.ws + WS_DT);
    const bf16_t* prevb = (const bf16_t*)a.out;
    LAS float* f32a = (LAS float*)(lds + L_F32); LAS float* acs = f32a + 512; LAS float* dtl = f32a + 1024; LAS float* red = (LAS float*)(lds + L_RED);
    for (int unit = blockIdx.x; unit < 256; unit += gridDim.x) {
        const int g = unit & 3, c = (unit >> 2) & 15, b = unit >> 6, m0 = b * SEQ + c * 128;
        __syncthreads();
        ssd_dt(f32a, dtbuf, a.in[11], m0, g);
        ssd_build<1>(lds, proj, a.in[8], a.in[9], c, m0, g, nullptr);
        __syncthreads();
        const int hh = wid >> 1, pb = wid & 1, head = g * 4 + hh, prow = 32 * pb + l31;
        bf16x8 pf[8];
        { const bf16_t* pp = prevb + (size_t)((b * 16 + c) * 16 + head) * 8192 + prow * 128 + 8 * hi;
#pragma unroll
          for (int ks = 0; ks < 8; ++ks) pf[ks] = *(const bf16x8*)(pp + 16 * ks); }
        const float dsk = a.in[12][head];
        u32x2 zw[4][4];
#pragma unroll
        for (int lb = 0; lb < 4; ++lb) { const bf16_t* zrow = proj + (size_t)(m0 + 32 * lb + l31) * NPROJ + PC_Z + head * 64 + 32 * pb + 4 * hi;
#pragma unroll
            for (int rg = 0; rg < 4; ++rg) zw[lb][rg] = *(const u32x2*)(zrow + 8 * rg); }
        f32x16 y[4];
#pragma unroll
        for (int lb = 0; lb < 4; ++lb) {
            bf16x8 cf[8];
#pragma unroll
            for (int ks = 0; ks < 8; ++ks) cf[ks] = *(const LAS bf16x8*)(lds + L_C + (32 * lb + l31) * SROW + (16 * ks + 8 * hi) * 2);
            f32x16 acc = zero16();
#pragma unroll
            for (int ks = 0; ks < 8; ++ks) acc = MFMA32(pf[ks], cf[ks], acc);
            const int l = 32 * lb + l31; const float al = acs[hh * 128 + l]; const float el = __expf(al);
#pragma unroll
            for (int r = 0; r < 16; ++r) acc[r] *= el;
            for (int sb = 0; sb <= lb; ++sb) {
                f32x16 cbt = zero16();
#pragma unroll
                for (int ks = 0; ks < 8; ++ks) { const bf16x8 bfr = *(const LAS bf16x8*)(lds + L_B + (32 * sb + l31) * SROW + (16 * ks + 8 * hi) * 2); cbt = MFMA32(bfr, cf[ks], cbt); }
                float wv[16];
#pragma unroll
                for (int rg = 0; rg < 4; ++rg) { const int s0 = 32 * sb + 8 * rg + 4 * hi;
                    const f32x4 as4 = *(const LAS f32x4*)(acs + hh * 128 + s0), dt4 = *(const LAS f32x4*)(dtl + hh * 128 + s0);
#pragma unroll
                    for (int e = 0; e < 4; ++e) { const float v = cbt[4 * rg + e] * __expf(al - as4[e]) * dt4[e]; wv[4 * rg + e] = (s0 + e <= l) ? v : 0.f; } }
                const bf16x8 w0 = pack8(wv[0], wv[1], wv[2], wv[3], wv[4], wv[5], wv[6], wv[7]);
                const bf16x8 w1 = pack8(wv[8], wv[9], wv[10], wv[11], wv[12], wv[13], wv[14], wv[15]);
                const LAS unsigned char* xrowb = lds + L_XT + (hh * 64 + prow) * SROW; const int xs_ = swz(hh * 64 + prow), c0_ = 32 * sb + 4 * hi;
                { const s16x4 lo = *(const LAS s16x4*)(xrowb + ((c0_) ^ xs_) * 2), hi4 = *(const LAS s16x4*)(xrowb + ((c0_ + 8) ^ xs_) * 2);
                  bf16x8 af; af[0] = lo[0]; af[1] = lo[1]; af[2] = lo[2]; af[3] = lo[3]; af[4] = hi4[0]; af[5] = hi4[1]; af[6] = hi4[2]; af[7] = hi4[3];
                  acc = MFMA32(af, w0, acc); }
                { const s16x4 lo = *(const LAS s16x4*)(xrowb + ((c0_ + 16) ^ xs_) * 2), hi4 = *(const LAS s16x4*)(xrowb + ((c0_ + 24) ^ xs_) * 2);
                  bf16x8 af; af[0] = lo[0]; af[1] = lo[1]; af[2] = lo[2]; af[3] = lo[3]; af[4] = hi4[0]; af[5] = hi4[1]; af[6] = hi4[2]; af[7] = hi4[3];
                  acc = MFMA32(af, w1, acc); }
            }
            float ss = 0.f;
#pragma unroll
            for (int rg = 0; rg < 4; ++rg) { const u32x2 zq = zw[lb][rg];
                const float zf[4] = {bflo(zq.x), bfhi(zq.x), bflo(zq.y), bfhi(zq.y)};
#pragma unroll
                for (int e = 0; e < 4; ++e) { const int p = 32 * pb + 8 * rg + 4 * hi + e;
                    const float xv = __uint_as_float((unsigned)(*(const LAS unsigned short*)(lds + L_XT + (hh * 64 + p) * SROW + (l ^ swz(hh * 64 + p)) * 2)) << 16);
                    float v = acc[4 * rg + e] + dsk * xv; v *= zf[e] * __builtin_amdgcn_rcpf(1.0f + __expf(-zf[e])); acc[4 * rg + e] = v; ss += v * v; } }
            ss += __shfl_xor(ss, 32);
            if (hi == 0) red[wid * 128 + l] = ss;
            y[lb] = acc;
        }
        __syncthreads();
        const float* gso = a.in[13] + head * 64 + 32 * pb + 4 * hi;
#pragma unroll
        for (int lb = 0; lb < 4; ++lb) { const int l = 32 * lb + l31; float tot = 0.f;
#pragma unroll
            for (int w = 0; w < 8; ++w) tot += red[w * 128 + l];
            const float rstd = rsqrtf(tot * (1.0f / 256.0f) + EPS);
            bf16_t* orow = proj + (size_t)(m0 + l) * NPROJ + PC_Z + head * 64 + 32 * pb + 4 * hi;
#pragma unroll
            for (int rg = 0; rg < 4; ++rg) { const f32x4 g4 = *(const f32x4*)(gso + 8 * rg);
                u32x2 w; w.x = pk2(y[lb][4 * rg] * rstd * g4[0], y[lb][4 * rg + 1] * rstd * g4[1]); w.y = pk2(y[lb][4 * rg + 2] * rstd * g4[2], y[lb][4 * rg + 3] * rstd * g4[3]);
                *(u32x2*)(orow + 8 * rg) = w; } }
    }
}

constexpr int AKROW = 144, AVROW = 784, LA_K = 0, LA_V = 384 * AKROW, ATT_UNITS = 3 * 512;
__device__ __forceinline__ int attn_row_token(int br, int blk, int j) {
    if (br == 0) { return 256 * blk - 128 + j; }
    if (br == 1) { const int idx = 256 * (blk & 1) - 128 + j; return idx < 0 ? -1 : (blk >> 1) + 4 * idx; }
    if (j >= 256) return -1;
    return 2 * blk + (j >> 7) + 16 * (j & 127);
}
__device__ __forceinline__ void attn_load(const bf16_t* proj, int u, u32x4 (&kr)[6], u32x4 (&vr)[6]) {
    const int tid = threadIdx.x, blk = u & 7, hd = (u >> 3) & 15, b = (u >> 7) & 3, br = u >> 9;
#pragma unroll
    for (int i = 0; i < 6; ++i) {
        const int c = tid + 512 * i;
        { const int j = c >> 3, cc = c & 7, t = attn_row_token(br, blk, j);
          kr[i] = (t >= 0) ? *(const u32x4*)(proj + ((size_t)b * SEQ + t) * NPROJ + PC_K + hd * 64 + cc * 8) : (u32x4){0u, 0u, 0u, 0u}; }
        { const int j = c >> 3, cc = c & 7, t = attn_row_token(br, blk, j);
          vr[i] = (t >= 0) ? *(const u32x4*)(proj + ((size_t)b * SEQ + t) * NPROJ + PC_V + hd * 64 + cc * 8) : (u32x4){0u, 0u, 0u, 0u}; }
    }
}
__device__ __forceinline__ void attn_store(LAS unsigned char* lds, const u32x4 (&kr)[6], const u32x4 (&vr)[6]) {
    const int tid = threadIdx.x;
#pragma unroll
    for (int i = 0; i < 6; ++i) {
        const int c = tid + 512 * i;
        { const int j = c >> 3, cc = c & 7; *(LAS u32x4*)(lds + LA_K + j * AKROW + cc * 16) = kr[i]; }
        { const int j = c >> 3, cc = c & 7, col = j ^ (8 * cc); const unsigned wv[4] = {vr[i].x, vr[i].y, vr[i].z, vr[i].w};
#pragma unroll
          for (int e = 0; e < 4; ++e) { *(LAS unsigned short*)(lds + LA_V + (cc * 8 + 2 * e) * AVROW + col * 2) = (unsigned short)(wv[e] & 0xffffu);
              *(LAS unsigned short*)(lds + LA_V + (cc * 8 + 2 * e + 1) * AVROW + col * 2) = (unsigned short)(wv[e] >> 16); } }
    }
}
__device__ __forceinline__ void p3_attn(const Args& a, LAS unsigned char* lds) {
    const int tid = threadIdx.x, lane = tid & 63, wid = tid >> 6, l31 = lane & 31, hi = lane >> 5;
    const bf16_t* proj = (const bf16_t*)(a.ws + WS_PROJ); bf16_t* obr = (bf16_t*)(a.ws + WS_OBR); float* lse = (float*)(a.ws + WS_LSE);
    unsigned* qctr = (unsigned*)(a.ws + WS_BAR) + 3584;
    const unsigned myx = ((unsigned)__builtin_amdgcn_s_getreg((3 << 11) | 20)) & 7u;
#define ATT_FETCH() do { unsigned got_ = (unsigned)ATT_UNITS; \
        for (unsigned t_ = 0; t_ < 8u; ++t_) { const unsigned xq_ = (myx + t_) & 7u; const unsigned i_ = atomicAdd(qctr + 64 * xq_, 1u); \
            if (i_ < 192u) { const unsigned p_ = xq_ + 8u * (i_ / 24u), sub_ = i_ % 24u; got_ = (sub_ >> 3) * 512u + p_ * 8u + (sub_ & 7u); break; } } \
        qnext[0] = got_; } while (0)
    volatile LAS unsigned* qnext = (volatile LAS unsigned*)(lds + LDS_BYTES - 32);
    u32x4 kr[6], vr[6];
    __syncthreads();
    if (tid == 0) ATT_FETCH();
    __syncthreads();
    int u = (int)qnext[0];
    bf16x8 qn[4];
#define ATT_GEOM(uu, tq_, rowt0_, kt0_) do { const int blk_ = (uu) & 7, br_ = (uu) >> 9; \
        if (br_ < 2) { const int base_q = (br_ == 0) ? 256 * blk_ : 256 * (blk_ & 1), r_ = (br_ == 0) ? 0 : (blk_ >> 1), d_ = (br_ == 0) ? 1 : 4; \
            tq_ = r_ + d_ * (base_q + 32 * wid + l31); rowt0_ = 32 * wid; const int q32 = (base_q >> 5) + wid; kt0_ = (q32 >= 4) ? 0 : 4 - q32; } \
        else { const int rsel = wid >> 2, wq = wid & 3; tq_ = 2 * blk_ + rsel + 16 * (32 * wq + l31); rowt0_ = 128 * rsel + 32 * wq - 128; kt0_ = 4 - wq; } } while (0)
#define ATT_QLOAD(uu) do { int tq_, r0_, k0_; ATT_GEOM(uu, tq_, r0_, k0_); (void)r0_; (void)k0_; const size_t mq_ = (size_t)(((uu) >> 7) & 3) * SEQ + tq_; \
        _Pragma("unroll") for (int kk = 0; kk < 4; ++kk) qn[kk] = *(const bf16x8*)(proj + mq_ * NPROJ + PC_Q + (((uu) >> 3) & 15) * 64 + 16 * kk + 8 * hi); } while (0)
    if (u < ATT_UNITS) { attn_load(proj, u, kr, vr); ATT_QLOAD(u); }
    while (u < ATT_UNITS) {
        __syncthreads();
        attn_store(lds, kr, vr);
        if (tid == 0) ATT_FETCH();
        __syncthreads();
        const int un = (int)qnext[0];
        bf16x8 qf[4];
#pragma unroll
        for (int kk = 0; kk < 4; ++kk) qf[kk] = qn[kk];
        if (un < ATT_UNITS) { attn_load(proj, un, kr, vr); ATT_QLOAD(un); }
        const int blk = u & 7, hd = (u >> 3) & 15, b = (u >> 7) & 3, br = u >> 9;
        int tq, rowt0, kt0; ATT_GEOM(u, tq, rowt0, kt0);
        const size_t mq = (size_t)b * SEQ + tq;
        float m_run = -INFINITY, l_run = 0.f; f32x16 acc[2]; acc[0] = zero16(); acc[1] = zero16();
        for (int kt = kt0; kt < 5; ++kt) {
            const int row0 = rowt0 + 32 * kt;
            f32x16 st = zero16();
#pragma unroll
            for (int kk = 0; kk < 4; ++kk) { const bf16x8 kf = *(const LAS bf16x8*)(lds + LA_K + (row0 + l31) * AKROW + (16 * kk + 8 * hi) * 2); st = MFMA32(kf, qf[kk], st); }
            const int dbase = 128 - 32 * kt + l31 - 4 * hi; float mx = -INFINITY;
#pragma unroll
            for (int rr = 0; rr < 16; ++rr) { const int dist = dbase - ((rr & 3) + 8 * (rr >> 2)); const bool ok = (dist >= 0) && (dist <= 128); st[rr] = ok ? st[rr] : -INFINITY; mx = fmaxf(mx, st[rr]); }
            mx = fmaxf(mx, __shfl_xor(mx, 32));
            const float m_new = fmaxf(m_run, mx), alpha = __expf(m_run - m_new); float psum = 0.f;
#pragma unroll
            for (int rr = 0; rr < 16; ++rr) { st[rr] = __expf(st[rr] - m_new); psum += st[rr]; }
            psum += __shfl_xor(psum, 32);
            l_run = l_run * alpha + psum; m_run = m_new;
#pragma unroll
            for (int rr = 0; rr < 16; ++rr) { acc[0][rr] *= alpha; acc[1][rr] *= alpha; }
            const bf16x8 p0 = pack8(st[0], st[1], st[2], st[3], st[4], st[5], st[6], st[7]);
            const bf16x8 p1 = pack8(st[8], st[9], st[10], st[11], st[12], st[13], st[14], st[15]);
#pragma unroll
            for (int db = 0; db < 2; ++db) {
                const LAS unsigned char* vrowb = lds + LA_V + (32 * db + l31) * AVROW; const int vsw = 8 * (((32 * db + l31) >> 3) & 7), vc0 = row0 + 4 * hi;
                { const s16x4 lo = *(const LAS s16x4*)(vrowb + ((vc0) ^ vsw) * 2), h4 = *(const LAS s16x4*)(vrowb + ((vc0 + 8) ^ vsw) * 2);
                  bf16x8 af; af[0] = lo[0]; af[1] = lo[1]; af[2] = lo[2]; af[3] = lo[3]; af[4] = h4[0]; af[5] = h4[1]; af[6] = h4[2]; af[7] = h4[3];
                  acc[db] = MFMA32(af, p0, acc[db]); }
                { const s16x4 lo = *(const LAS s16x4*)(vrowb + ((vc0 + 16) ^ vsw) * 2), h4 = *(const LAS s16x4*)(vrowb + ((vc0 + 24) ^ vsw) * 2);
                  bf16x8 af; af[0] = lo[0]; af[1] = lo[1]; af[2] = lo[2]; af[3] = lo[3]; af[4] = h4[0]; af[5] = h4[1]; af[6] = h4[2]; af[7] = h4[3];
                  acc[db] = MFMA32(af, p1, acc[db]); }
            }
        }
        const float inv = 1.0f / l_run;
        bf16_t* op = obr + ((size_t)br * MTOK + mq) * 1024 + hd * 64 + 4 * hi;
#pragma unroll
        for (int db = 0; db < 2; ++db)
#pragma unroll
            for (int rg = 0; rg < 4; ++rg) { u32x2 w; w.x = pk2(acc[db][4 * rg] * inv, acc[db][4 * rg + 1] * inv); w.y = pk2(acc[db][4 * rg + 2] * inv, acc[db][4 * rg + 3] * inv);
                *(u32x2*)(op + 32 * db + 8 * rg) = w; }
        if (hi == 0) lse[((size_t)br * MTOK + mq) * 16 + hd] = m_run + __logf(l_run);
        u = un;
    }
}

__device__ __forceinline__ void p4_combine(const Args& a) {
    const int tid = threadIdx.x, lane = tid & 63, wid = tid >> 6;
    bf16_t* proj = (bf16_t*)(a.ws + WS_PROJ); const bf16_t* obr = (const bf16_t*)(a.ws + WS_OBR); const float* lse = (const float*)(a.ws + WS_LSE);
    const float* gao = a.in[7];
    const int gw = blockIdx.x * 8 + wid, NGW = gridDim.x * 8;
    for (int m = gw; m < MTOK; m += NGW) {
        const int hd = lane >> 2;
        const float l0 = lse[((size_t)0 * MTOK + m) * 16 + hd], l1 = lse[((size_t)1 * MTOK + m) * 16 + hd], l2 = lse[((size_t)2 * MTOK + m) * 16 + hd];
        const float mx = fmaxf(l0, fmaxf(l1, l2)); const float e0 = __expf(l0 - mx), e1 = __expf(l1 - mx), e2 = __expf(l2 - mx); const float inv = 1.0f / (e0 + e1 + e2);
        const float wg[3] = {e0 * inv, e1 * inv, e2 * inv};
        float v[16];
#pragma unroll
        for (int e = 0; e < 16; ++e) v[e] = 0.f;
#pragma unroll
        for (int gI = 0; gI < 3; ++gI) { const bf16_t* p = obr + ((size_t)gI * MTOK + m) * 1024 + lane * 16;
#pragma unroll
            for (int c = 0; c < 2; ++c) { const u32x4 w = *(const u32x4*)(p + 8 * c);
                v[8 * c + 0] += wg[gI] * bflo(w.x); v[8 * c + 1] += wg[gI] * bfhi(w.x); v[8 * c + 2] += wg[gI] * bflo(w.y); v[8 * c + 3] += wg[gI] * bfhi(w.y);
                v[8 * c + 4] += wg[gI] * bflo(w.z); v[8 * c + 5] += wg[gI] * bfhi(w.z); v[8 * c + 6] += wg[gI] * bflo(w.w); v[8 * c + 7] += wg[gI] * bfhi(w.w); } }
        float ss = 0.f;
#pragma unroll
        for (int e = 0; e < 16; ++e) ss += v[e] * v[e];
        ss = wave_sum(ss); const float rstd = rsqrtf(ss * (1.0f / 1024.0f) + EPS);
        bf16_t* op = proj + (size_t)m * NPROJ + PC_Q + lane * 16;
#pragma unroll
        for (int c = 0; c < 2; ++c) { const f32x4 g0 = *(const f32x4*)(gao + lane * 16 + 8 * c), g1 = *(const f32x4*)(gao + lane * 16 + 8 * c + 4);
            u32x4 w; w.x = pk2(v[8 * c] * rstd * g0[0], v[8 * c + 1] * rstd * g0[1]); w.y = pk2(v[8 * c + 2] * rstd * g0[2], v[8 * c + 3] * rstd * g0[3]);
            w.z = pk2(v[8 * c + 4] * rstd * g1[0], v[8 * c + 5] * rstd * g1[1]); w.w = pk2(v[8 * c + 6] * rstd * g1[2], v[8 * c + 7] * rstd * g1[3]);
            *(u32x4*)(op + 8 * c) = w; }
    }
}

__device__ __forceinline__ void p5_kvprep(const Args& a) {
    const int tid = threadIdx.x, lane = tid & 63, wid = tid >> 6;
    const float* kvp = (const float*)(a.ws + WS_KVPART); const float* rstdm = (const float*)(a.ws + WS_RSTDM);
    bf16_t* kc = (bf16_t*)(a.ws + WS_KC); bf16_t* vct = (bf16_t*)(a.ws + WS_VCT); const float* gck = a.in[20];
    const int gw = blockIdx.x * 8 + wid, NGW = gridDim.x * 8;
    for (int it = gw; it < MMEM * 4; it += NGW) {
        const int mm = it >> 2, h = it & 3, b = mm >> 8, j = mm & 255; const float rs = rstdm[mm];
        float k0 = 0.f, k1 = 0.f, v0 = 0.f, v1 = 0.f;
#pragma unroll
        for (int ks = 0; ks < 2; ++ks) { const float* p = kvp + ((size_t)ks * MMEM + mm) * 1024 + h * 128 + 2 * lane;
            const f32x2 kk = *(const f32x2*)p, vv = *(const f32x2*)(p + 512); k0 += kk[0]; k1 += kk[1]; v0 += vv[0]; v1 += vv[1]; }
        k0 *= rs; k1 *= rs; v0 *= rs; v1 *= rs;
        const float ss = wave_sum(k0 * k0 + k1 * k1); const float r = rsqrtf(ss * (1.0f / 128.0f) + EPS);
        *(unsigned*)(kc + ((size_t)(b * 4 + h) * 256 + j) * 128 + 2 * lane) = pk2(k0 * r * gck[2 * lane], k1 * r * gck[2 * lane + 1]);
        vct[((size_t)(b * 4 + h) * 128 + 2 * lane) * 256 + j] = (bf16_t)f2bf(v0);
        vct[((size_t)(b * 4 + h) * 128 + 2 * lane + 1) * 256 + j] = (bf16_t)f2bf(v1);
    }
}

constexpr int KROW = 272, VTROW = 528, LX_K = 0, LX_V = 256 * KROW;
__device__ __forceinline__ void p6_cross(const Args& a, LAS unsigned char* lds) {
    const int tid = threadIdx.x, lane = tid & 63, wid = tid >> 6, l31 = lane & 31, hi = lane >> 5;
    const bf16_t* qp = (const bf16_t*)(a.ws + WS_QPART); const float* sumsq1 = (const float*)(a.ws + WS_SUMSQ1);
    const bf16_t* kc = (const bf16_t*)(a.ws + WS_KC); const bf16_t* vct = (const bf16_t*)(a.ws + WS_VCT); bf16_t* co = (bf16_t*)(a.ws + WS_CO);
    const float* gcq = a.in[19];
    for (int u = blockIdx.x; u < 128; u += gridDim.x) {
        const int qb8 = u & 7, h = (u >> 3) & 3, b = u >> 5; const size_t mq = (size_t)b * SEQ + 256 * qb8 + 32 * wid + l31;
        __syncthreads();
        { const bf16_t* kbase = kc + (size_t)(b * 4 + h) * 256 * 128; const bf16_t* vbase = vct + (size_t)(b * 4 + h) * 128 * 256;
#pragma unroll
          for (int i = 0; i < 8; ++i) { const int ch = tid + 512 * i; const int row = ch >> 4, c16 = ch & 15; *(LAS u32x4*)(lds + LX_K + row * KROW + c16 * 16) = *(const u32x4*)(kbase + row * 128 + c16 * 8); }
#pragma unroll
          for (int i = 0; i < 8; ++i) { const int ch = tid + 512 * i; const int row = ch >> 5, c16 = ch & 31; *(LAS u32x4*)(lds + LX_V + row * VTROW + c16 * 16) = *(const u32x4*)(vbase + row * 256 + c16 * 8); } }
        const float rs1 = rsqrtf(sumsq1[mq] * (1.0f / DM) + EPS);
        bf16x8 qf[8];
        { float qv[8][8]; float ss = 0.f;
#pragma unroll
          for (int kk = 0; kk < 8; ++kk) {
#pragma unroll
              for (int j = 0; j < 8; ++j) qv[kk][j] = 0.f;
#pragma unroll
              for (int ks = 0; ks < 4; ++ks) { const u32x4 w = *(const u32x4*)(qp + ((size_t)ks * MTOK + mq) * DCROSS + h * 128 + 16 * kk + 8 * hi);
                  qv[kk][0] += bflo(w.x); qv[kk][1] += bfhi(w.x); qv[kk][2] += bflo(w.y); qv[kk][3] += bfhi(w.y); qv[kk][4] += bflo(w.z); qv[kk][5] += bfhi(w.z); qv[kk][6] += bflo(w.w); qv[kk][7] += bfhi(w.w); }
#pragma unroll
              for (int j = 0; j < 8; ++j) { qv[kk][j] *= rs1; ss += qv[kk][j] * qv[kk][j]; } }
          ss += __shfl_xor(ss, 32);
          const float r = rsqrtf(ss * (1.0f / 128.0f) + EPS) * 0.08838834764831845f;
#pragma unroll
          for (int kk = 0; kk < 8; ++kk) { const f32x4 g0 = *(const f32x4*)(gcq + 16 * kk + 8 * hi), g1 = *(const f32x4*)(gcq + 16 * kk + 8 * hi + 4);
              qf[kk] = pack8(qv[kk][0] * r * g0[0], qv[kk][1] * r * g0[1], qv[kk][2] * r * g0[2], qv[kk][3] * r * g0[3], qv[kk][4] * r * g1[0], qv[kk][5] * r * g1[1], qv[kk][6] * r * g1[2], qv[kk][7] * r * g1[3]); }
        }
        __syncthreads();
        float m_run = -INFINITY, l_run = 0.f; f32x16 acc[4];
#pragma unroll
        for (int db = 0; db < 4; ++db) acc[db] = zero16();
        for (int kt = 0; kt < 8; ++kt) {
            f32x16 st = zero16();
#pragma unroll
            for (int kk = 0; kk < 8; ++kk) { const bf16x8 kf = *(const LAS bf16x8*)(lds + LX_K + (32 * kt + l31) * KROW + (16 * kk + 8 * hi) * 2); st = MFMA32(kf, qf[kk], st); }
            float mx = -INFINITY;
#pragma unroll
            for (int rr = 0; rr < 16; ++rr) mx = fmaxf(mx, st[rr]);
            mx = fmaxf(mx, __shfl_xor(mx, 32));
            const float m_new = fmaxf(m_run, mx), alpha = __expf(m_run - m_new); float psum = 0.f;
#pragma unroll
            for (int rr = 0; rr < 16; ++rr) { st[rr] = __expf(st[rr] - m_new); psum += st[rr]; }
            psum += __shfl_xor(psum, 32);
            l_run = l_run * alpha + psum; m_run = m_new;
            const bf16x8 p0 = pack8(st[0], st[1], st[2], st[3], st[4], st[5], st[6], st[7]);
            const bf16x8 p1 = pack8(st[8], st[9], st[10], st[11], st[12], st[13], st[14], st[15]);
#pragma unroll
            for (int db = 0; db < 4; ++db) {
#pragma unroll
                for (int rr = 0; rr < 16; ++rr) acc[db][rr] *= alpha;
                const LAS unsigned char* vrow = lds + LX_V + (32 * db + l31) * VTROW + (32 * kt + 4 * hi) * 2;
                { const s16x4 lo = *(const LAS s16x4*)(vrow), h4 = *(const LAS s16x4*)(vrow + 16);
                  bf16x8 af; af[0] = lo[0]; af[1] = lo[1]; af[2] = lo[2]; af[3] = lo[3]; af[4] = h4[0]; af[5] = h4[1]; af[6] = h4[2]; af[7] = h4[3];
                  acc[db] = MFMA32(af, p0, acc[db]); }
                { const s16x4 lo = *(const LAS s16x4*)(vrow + 32), h4 = *(const LAS s16x4*)(vrow + 48);
                  bf16x8 af; af[0] = lo[0]; af[1] = lo[1]; af[2] = lo[2]; af[3] = lo[3]; af[4] = h4[0]; af[5] = h4[1]; af[6] = h4[2]; af[7] = h4[3];
                  acc[db] = MFMA32(af, p1, acc[db]); }
            }
        }
        const float inv = 1.0f / l_run;
        bf16_t* op = co + mq * DCROSS + h * 128 + 4 * hi;
#pragma unroll
        for (int db = 0; db < 4; ++db)
#pragma unroll
            for (int rg = 0; rg < 4; ++rg) { u32x2 w; w.x = pk2(acc[db][4 * rg] * inv, acc[db][4 * rg + 1] * inv); w.y = pk2(acc[db][4 * rg + 2] * inv, acc[db][4 * rg + 3] * inv);
                *(u32x2*)(op + 32 * db + 8 * rg) = w; }
    }
}

#define XB_TMO      128
#define XB_XCNT(j)  (256  + 64 * (j))
#define XB_XSUB(j)  (1280 + 64 * (j))
#define XB_XGEN(j)  (2304 + 64 * (j))
#define XB_TOP      3328
#define XB_TOPGEN   3392
#define XCD_BAR_WORDS 3456
#define XB_SPIN_CAP (1u << 18)
__device__ __forceinline__ unsigned xb_ld(unsigned* p)              { return __hip_atomic_load(p, __ATOMIC_RELAXED, __HIP_MEMORY_SCOPE_AGENT); }
__device__ __forceinline__ unsigned xb_add(unsigned* p, unsigned v) { return __hip_atomic_fetch_add(p, v, __ATOMIC_RELAXED, __HIP_MEMORY_SCOPE_AGENT); }
__device__ __forceinline__ unsigned xb_xcc_id() { return (unsigned)__builtin_amdgcn_s_getreg((3 << 11) | 20) & 0xFu; }
#define XB_SPIN(cond, bar) do { unsigned _sp = 0; while (cond) { __builtin_amdgcn_s_sleep(1); \
    if ((++_sp & 255u) == 0u) { if (xb_ld(&(bar)[XB_TMO])) break; if (_sp > XB_SPIN_CAP) { atomicAdd(&(bar)[XB_TMO], 1u); break; } } } } while (0)
struct XcdBarrier { unsigned* bar; unsigned x; volatile LAS unsigned* st; };
__device__ __forceinline__ XcdBarrier xcd_barrier_post(unsigned* bar, volatile LAS unsigned* st) {
    XcdBarrier b; b.bar = bar; b.x = xb_xcc_id(); b.st = st;
    if (threadIdx.x == 0) (void)xb_add(&bar[XB_XCNT(b.x)], 1u);
    return b;
}
__device__ __forceinline__ void xcd_barrier_complete(unsigned* bar, unsigned x, unsigned& nloc, unsigned& nx) {
    const unsigned G = gridDim.x * gridDim.y * gridDim.z;
    unsigned sum, cnt, mine, sp = 0u;
    for (;;) {
        sum = 0u; cnt = 0u; mine = 0u;
#pragma unroll
        for (unsigned j = 0; j < 16; ++j) { const unsigned c = xb_ld(&bar[XB_XCNT(j)]); sum += c; cnt += (c > 0u) ? 1u : 0u; mine = (j == x) ? c : mine; }
        if (sum == G) break;
        __builtin_amdgcn_s_sleep(1);
        if ((++sp & 255u) == 0u) { if (xb_ld(&bar[XB_TMO])) break; if (sp > XB_SPIN_CAP) { atomicAdd(&bar[XB_TMO], 1u); break; } }
    }
    nloc = mine > 0u ? mine : 1u; nx = cnt > 0u ? cnt : 1u;
}
__device__ __forceinline__ void xcd_barrier(const XcdBarrier& b) {
    asm volatile("s_waitcnt vmcnt(0)" ::: "memory");
    __syncthreads();
    if (threadIdx.x == 0) {
        unsigned* bar = b.bar;
        __builtin_amdgcn_s_waitcnt(0);
        unsigned nloc = b.st[0], nx = b.st[1];
        if (nloc == 0u) { xcd_barrier_complete(bar, b.x, nloc, nx); b.st[0] = nloc; b.st[1] = nx; }
        const unsigned old = xb_add(&bar[XB_XSUB(b.x)], 1u);
        const unsigned gen = old / nloc;
        if (old + 1u == (gen + 1u) * nloc) {
            __builtin_amdgcn_fence(__ATOMIC_RELEASE, "agent");
            asm volatile("s_waitcnt vmcnt(0)" ::: "memory");
            const unsigned og = xb_add(&bar[XB_TOP], 1u);
            const unsigned tg = og / nx;
            if (og + 1u == (tg + 1u) * nx) xb_add(&bar[XB_TOPGEN], 1u);
            else XB_SPIN(xb_ld(&bar[XB_TOPGEN]) == tg, bar);
            __builtin_amdgcn_fence(__ATOMIC_ACQUIRE, "agent");
            xb_add(&bar[XB_XGEN(b.x)], 1u);
            asm volatile("s_waitcnt vmcnt(0)" ::: "memory");
        } else {
            XB_SPIN(xb_ld(&bar[XB_XGEN(b.x)]) == gen, bar);
            __builtin_amdgcn_fence(__ATOMIC_ACQUIRE, "agent");
            asm volatile("s_waitcnt vmcnt(0)" ::: "memory");
        }
    }
    __syncthreads();
}

__global__ void __launch_bounds__(512, 2) mega_fwd(Args a) {
    extern __shared__ __attribute__((aligned(16))) unsigned char lds_raw[];
    LAS unsigned char* lds = (LAS unsigned char*)lds_raw;
    unsigned char* ws = a.ws;
    const int G = gridDim.x, cb = blockIdx.x;
    const int lo = a.lo, hi = a.hi;
#define IN(k) (lo <= (k) && (k) < hi)
#if MK_COOP
    volatile LAS unsigned* bst = (volatile LAS unsigned*)(lds + LDS_BYTES - 64);
    if (threadIdx.x < 2) bst[threadIdx.x] = 0u;
    __syncthreads();
    XcdBarrier xbar = xcd_barrier_post((unsigned*)(ws + WS_BAR), bst);
    if (lo < 0) cg::this_grid().sync();
#define SEAM(k) do { if ((k) + 1 < hi) { xcd_barrier(xbar); } } while (0)
#else
#define SEAM(k) do { } while (0)
#endif
    if (IN(0)) { p0_prologue(a, lds); if (PROBE_DUP == 0) { __syncthreads(); p0_prologue(a, lds); } SEAM(0); }
    if (IN(1)) {
        pg8::Gemm g{(const bf16_t*)(ws + WS_XB), (const bf16_t*)(ws + WS_WIN), DM, DM, MTOK / 256, NPROJ / 256, 1, DM, G, cb};
        pg8::EpiScaleBf16<0, 0> E{(bf16_t*)(ws + WS_PROJ), NPROJ, (const float*)(ws + WS_RSTD0)};
        pg8::gemm_phase(lds, g, E); if (PROBE_DUP == 1) pg8::gemm_phase(lds, g, E); SEAM(1);
    }
    if (IN(2)) { p2_ssd_states(a, lds); if (PROBE_DUP == 2) p2_ssd_states(a, lds); p2_qkprep(a); SEAM(2); }
    if (IN(3)) {
        { pg8::Gemm g{(const bf16_t*)(ws + WS_MEMB), (const bf16_t*)(ws + WS_WCKV), DM, DM, MMEM / 256, (2 * DCROSS) / 256, 2, DM / 2, G, cb};
          pg8::EpiPart E{(float*)(ws + WS_KVPART), 2 * DCROSS, (size_t)MMEM * 2 * DCROSS};
          pg8::gemm_phase(lds, g, E); }
        p3_scan(a); p3_attn(a, lds); SEAM(3);
    }
    if (IN(4)) { p3_ssd_out(a, lds); p4_combine(a); SEAM(4); }
    if (IN(5)) {
        pg8::Gemm g{(const bf16_t*)(ws + WS_PROJ), (const bf16_t*)(ws + WS_WOUT), NPROJ, DM, MTOK / 256, DM / 256, 1, DM, G, cb};
        pg8::EpiResid<0> E{a.in[0], nullptr, nullptr, (bf16_t*)(ws + WS_X1B), (float*)(ws + WS_SUMSQ1)};
        pg8::gemm_phase(lds, g, E); SEAM(5);
    }
    if (IN(6)) {
        pg8::Gemm g{(const bf16_t*)(ws + WS_X1B), (const bf16_t*)(ws + WS_WCQ), DM, DM, MTOK / 256, DCROSS / 256, 4, DM / 4, G, cb};
        pg8::EpiPartBf16 E{(bf16_t*)(ws + WS_QPART), DCROSS, (size_t)MTOK * DCROSS};
        pg8::gemm_phase(lds, g, E);
        p5_kvprep(a); SEAM(6);
    }
    if (IN(7)) {
        p6_cross(a, lds);
        {
            const int wv = threadIdx.x >> 6, ln = threadIdx.x & 63; LAS float* scr = (LAS float*)(lds + wv * 16640);
            __syncthreads();
            int i0, i1, w0, nw;
            if (G == 256) { if (blockIdx.x >= 128) { i0 = 0; i1 = 3200; w0 = (blockIdx.x - 128) * 8 + wv; } else { i0 = 3200; i1 = 4096; w0 = blockIdx.x * 8 + wv; } nw = 1024; }
            else { i0 = 0; i1 = 4096; w0 = blockIdx.x * 8 + wv; nw = G * 8; }
            for (int it = i0 + w0; it < i1; it += nw) { int r = it; p0_mat(r, a.in[24], DFF, DM, DM, (bf16_t*)(ws + WS_WDOWN), nullptr, false, scr, ln); }
        }
        SEAM(7);
    }
    if (IN(8)) {
        pg8::Gemm g{(const bf16_t*)(ws + WS_CO), (const bf16_t*)(ws + WS_WCO), DCROSS, DCROSS, MTOK / 256, DM / 256, 1, DCROSS, G, cb};
        pg8::EpiResid<1> E{nullptr, (const bf16_t*)(ws + WS_X1B), nullptr, (bf16_t*)(ws + WS_X2B), (float*)(ws + WS_SUMSQ2)};
        pg8::gemm_phase(lds, g, E); SEAM(8);
    }
    if (IN(9)) {
        pg8::Gemm g{(const bf16_t*)(ws + WS_X2B), (const bf16_t*)(ws + WS_WUP), DM, DM, MTOK / 256, DFF / 256, 1, DM, G, cb};
        pg8::EpiScaleBf16<1, 1> E{(bf16_t*)(ws + WS_HID), DFF, (const float*)(ws + WS_SUMSQ2)};
        pg8::gemm_phase(lds, g, E); if (PROBE_DUP == 9) pg8::gemm_phase(lds, g, E); SEAM(9);
    }
    if (IN(10)) {
        pg8::Gemm g{(const bf16_t*)(ws + WS_HID), (const bf16_t*)(ws + WS_WDOWN), DFF, DFF, MTOK / 256, DM / 256, 1, DFF, G, cb};
        pg8::EpiResid<2> E{nullptr, (const bf16_t*)(ws + WS_X2B), a.out, nullptr, nullptr};
        pg8::gemm_phase(lds, g, E);
    }
#undef IN
#undef SEAM
}

extern "C" void kernel_launch(void* const* d_in, const int* in_sizes, int n_in, void* d_out, int out_size, void* d_ws, size_t ws_size, hipStream_t stream) {
    static int grid = 0;
    if (grid == 0) {
        if (n_in != 25 || out_size != MTOK * DM || ws_size < WS_END) { fprintf(stderr, "kernel_launch: unexpected problem (n_in %d, out %d, ws %zu < %zu)\n", n_in, out_size, ws_size, (size_t)WS_END); grid = -1; return; }
        int dev = 0, cus = 0, per_cu = 0;
        hipGetDevice(&dev); hipDeviceGetAttribute(&cus, hipDeviceAttributeMultiprocessorCount, dev);
        if (hipFuncSetAttribute((const void*)mega_fwd, hipFuncAttributeMaxDynamicSharedMemorySize, LDS_BYTES) != hipSuccess) { fprintf(stderr, "kernel_launch: hipFuncSetAttribute failed\n"); grid = -1; return; }
        if (hipOccupancyMaxActiveBlocksPerMultiprocessor(&per_cu, (const void*)mega_fwd, 512, LDS_BYTES) != hipSuccess || per_cu < 1) { fprintf(stderr, "kernel_launch: occupancy query says %d\n", per_cu); per_cu = 1; }
        (void)hipGetLastError();
        grid = cus;
    }
    if (grid < 0) return;
    Args a{};
    for (int i = 0; i < 25; ++i) a.in[i] = (const float*)d_in[i];
    a.out = (float*)d_out; a.ws = (unsigned char*)d_ws;
#if MK_COOP
    a.lo = 0; a.hi = NPHASE;
    if (hipMemsetAsync((char*)d_ws + WS_BAR, 0, BAR_BYTES, stream) != hipSuccess) { fprintf(stderr, "kernel_launch: memset of the barrier words failed\n"); return; }
    void* args[] = {&a};
    hipError_t e = hipLaunchCooperativeKernel((const void*)mega_fwd, dim3(grid), dim3(512), args, LDS_BYTES, stream);
    if (e != hipSuccess) fprintf(stderr, "cooperative launch failed: %s (grid %d)\n", hipGetErrorString(e), grid);
#else
    for (int ph = 0; ph < NPHASE; ++ph) {
        a.lo = ph; a.hi = ph + 1;
        hipLaunchKernelGGL(mega_fwd, dim3(grid), dim3(512), LDS_BYTES, stream, a);
    }
#endif
}
```

```cpp
#include <hip/hip_runtime.h>
#include <hip/hip_cooperative_groups.h>
#include <cstdio>
#include <cstdint>
namespace cg = cooperative_groups;

#ifndef PROBE_DUP
#define PROBE_DUP -1
#endif
#ifndef MK_COOP
#define MK_COOP 1
#endif

#define LAS __attribute__((address_space(3)))
typedef unsigned short bf16_t;
typedef short bf16x8 __attribute__((ext_vector_type(8)));
typedef short s16x4 __attribute__((ext_vector_type(4)));
typedef float f32x2 __attribute__((ext_vector_type(2)));
typedef float f32x4 __attribute__((ext_vector_type(4)));
typedef float f32x16 __attribute__((ext_vector_type(16)));
typedef unsigned u32x4 __attribute__((ext_vector_type(4)));
typedef unsigned u32x2 __attribute__((ext_vector_type(2)));

constexpr int DM = 2048, NB = 4, SEQ = 2048, MTOK = NB * SEQ;
constexpr int DIN = 6160, NPROJ = 6144;
constexpr int NMEM = 256, MMEM = NB * NMEM, DCROSS = 512, DFF = 8192;
constexpr float EPS = 1e-6f;
constexpr int PC_Q = 0, PC_Z = 1024, PC_K = 2048, PC_V = 3072, PC_X = 4096;

constexpr size_t MiB = 1u << 20;
constexpr size_t WS_WOUT = 0, WS_WCQ = 8 * MiB, WS_WCKV = 10 * MiB, WS_WCO = 14 * MiB, WS_WUP = 16 * MiB, WS_WDOWN = 48 * MiB;
constexpr size_t WS_SMALL = 80 * MiB;
constexpr size_t WS_DT = WS_SMALL, WS_RSTD0 = WS_SMALL + 512 * 1024, WS_RSTDM = WS_RSTD0 + 32 * 1024, WS_SUMSQ1 = WS_RSTDM + 4096, WS_SUMSQ2 = WS_SUMSQ1 + 32 * 1024,
                 WS_ATOT = WS_SUMSQ2 + 32 * 1024, WS_LSE = WS_SMALL + 1 * MiB, WS_MEMB = WS_SMALL + 3 * MiB, WS_KC = WS_SMALL + 7 * MiB, WS_VCT = WS_SMALL + 8 * MiB;
constexpr size_t WS_BAR = WS_SMALL + 9 * MiB, BAR_BYTES = 16384;
constexpr size_t WS_WIN = 92 * MiB, WS_XB = 116 * MiB, WS_PROJ = 148 * MiB, WS_STATES = 244 * MiB;
constexpr size_t WS_OBR = 92 * MiB, WS_X1B = 92 * MiB, WS_KVPART = 140 * MiB, WS_QPART = 148 * MiB, WS_CO = 212 * MiB, WS_X2B = 220 * MiB, WS_HID = 92 * MiB;
constexpr size_t WS_END = 276 * MiB;

constexpr int LDS_BYTES = 155648;
constexpr int NPHASE = 11;

__device__ __forceinline__ unsigned f2bf(float f) { unsigned u = __float_as_uint(f); return (u + 0x7fffu + ((u >> 16) & 1u)) >> 16; }
__device__ __forceinline__ unsigned pk2(float lo, float hi) { unsigned r; asm volatile("v_cvt_pk_bf16_f32 %0, %1, %2" : "=v"(r) : "v"(lo), "v"(hi)); return r; }
__device__ __forceinline__ float bflo(unsigned w) { return __uint_as_float(w << 16); }
__device__ __forceinline__ float bfhi(unsigned w) { return __uint_as_float(w & 0xffff0000u); }
__device__ __forceinline__ float wave_sum(float v) {
#pragma unroll
    for (int o = 1; o < 64; o <<= 1) v += __shfl_xor(v, o);
    return v;
}
__device__ __forceinline__ bf16x8 pack8(float a0, float a1, float a2, float a3, float a4, float a5, float a6, float a7) {
    u32x4 w; w.x = pk2(a0, a1); w.y = pk2(a2, a3); w.z = pk2(a4, a5); w.w = pk2(a6, a7);
    return __builtin_bit_cast(bf16x8, w);
}
#define MFMA32(a, b, c) __builtin_amdgcn_mfma_f32_32x32x16_bf16((a), (b), (c), 0, 0, 0)
__device__ __forceinline__ f32x16 zero16() { f32x16 z;
#pragma unroll
    for (int i = 0; i < 16; ++i) z[i] = 0.f; return z; }

namespace pg8 {
constexpr int BM = 256, BK = 64, HALF = 128, HTB = HALF * BK * 2, NXCD = 8, WGM = 4;
__device__ __forceinline__ int lds_byte(int r, int c) { const int st = (r >> 4) * 2 + (c >> 5), rr = r & 15, cc = c & 31, ob = rr * 64 + cc * 2; return st * 1024 + (ob ^ (((ob >> 9) & 1) << 5)); }
__device__ __forceinline__ void stage_rc(int b, int& R, int& C) { const int st = b / 1024, sb = b % 1024, swz = sb ^ (((sb >> 9) & 1) << 5); R = (st >> 1) * 16 + swz / 64; C = (st & 1) * 32 + (swz % 64) / 2; }
__device__ __forceinline__ int perm32(int rho) { const int n = rho >> 4, i = rho & 15; return 8 * (i >> 2) + 4 * n + (i & 3); }

struct Unit { int pm, pn, ks; };
struct Gemm { const bf16_t* A; const bf16_t* Bt; int lda, ldb, nM, nN, nKS, Klen, G, c; };

__device__ __forceinline__ bool next_unit(const Gemm& g, int i, Unit& u) {
    const int nwg = g.nM * g.nN; const long L = (long)i * g.G + g.c; if (L >= (long)nwg * g.nKS) return false;
    u.ks = (int)(L / nwg); int wgid = (int)(L % nwg);
    { const int q = nwg / NXCD, r = nwg % NXCD, xcd = wgid % NXCD, off = wgid / NXCD; wgid = (xcd < r ? xcd * (q + 1) : r * (q + 1) + (xcd - r) * q) + off; }
    const int nig = WGM * g.nN, gid = wgid / nig, fm = gid * WGM, gsz = (g.nM - fm) < WGM ? (g.nM - fm) : WGM;
    u.pm = fm + ((wgid % nig) % gsz); u.pn = (wgid % nig) / gsz; return true;
}

template <class Epi>
__device__ __forceinline__ void gemm_phase(LAS unsigned char* lds, const Gemm g, const Epi& E) {
    const int tid = threadIdx.x, wid = __builtin_amdgcn_readfirstlane(tid >> 6), lane = tid & 63, wr = wid >> 2, wc = wid & 3, fr = lane & 15, fq = lane >> 4;
    const int nt = g.Klen / BK;
    unsigned voffA[2], voffB[2];
#pragma unroll
    for (int i = 0; i < 2; ++i) { int R, C; stage_rc(tid * 16 + i * 8192, R, C); const int Rb = Epi::PERM ? ((R & ~31) + perm32(R & 31)) : R;
        voffA[i] = (unsigned)(R * g.lda + C) * 2u; voffB[i] = (unsigned)(Rb * g.ldb + C) * 2u; }
    const size_t kstep = (size_t)(BK * 2);
    const size_t hstepA = (size_t)HALF * g.lda * 2, hstepB = (size_t)HALF * g.ldb * 2;
    const size_t tstepA = 2 * hstepA, tstepB = 2 * hstepB;
    const size_t ksoff = (size_t)g.Klen * 2;
    const unsigned ldsw = (unsigned)wid * 1024u;
    const int aoff = lds_byte(wr * 64 + fr, fq * 8), boff = lds_byte(wc * 32 + fr, fq * 8);
#define PG8_SA(b, h) (((b) * 2 + (h)) * HTB)
#define PG8_SB(b, h) ((4 + (b) * 2 + (h)) * HTB)
#define PG8_STAGE(bufoff, gbase, voff) do { _Pragma("unroll") for (int _i = 0; _i < 2; ++_i) \
        __builtin_amdgcn_global_load_lds((const unsigned*)((const char*)(gbase) + (voff)[_i]), (LAS unsigned*)(lds + (bufoff) + ldsw + _i * 8192), 16, 0, 0); } while (0)
#define PG8_LDA(dst, b, h) do { _Pragma("unroll") for (int m = 0; m < 4; ++m) _Pragma("unroll") for (int k = 0; k < 2; ++k) dst[m][k] = *(const LAS bf16x8*)(lds + PG8_SA(b, h) + aoff + m * 2048 + k * 1024); } while (0)
#define PG8_LDB(dst, b, h) do { _Pragma("unroll") for (int n = 0; n < 2; ++n) _Pragma("unroll") for (int k = 0; k < 2; ++k) dst[n][k] = *(const LAS bf16x8*)(lds + PG8_SB(b, h) + boff + n * 2048 + k * 1024); } while (0)
#define PG8_MMA(ai, bj, At, Bt) do { __builtin_amdgcn_s_setprio(1); _Pragma("unroll") for (int m = 0; m < 4; ++m) _Pragma("unroll") for (int n = 0; n < 2; ++n) _Pragma("unroll") for (int k = 0; k < 2; ++k) \
        acc[ai][bj][m][n] = __builtin_amdgcn_mfma_f32_16x16x32_bf16(Bt[n][k], At[m][k], acc[ai][bj][m][n], 0, 0, 0); __builtin_amdgcn_s_setprio(0); } while (0)
#define PG8_WAIT_V(n) asm volatile("s_waitcnt vmcnt(" #n ")" ::: "memory")
#define PG8_WAIT_L(n) asm volatile("s_waitcnt lgkmcnt(" #n ")" ::: "memory")
#define PG8_BAR __builtin_amdgcn_s_barrier()
#define PG8_SCHED __builtin_amdgcn_sched_barrier(0)
    Unit cur, nxt; int ui = 0;
    if (!next_unit(g, 0, cur)) return;
    f32x4 acc[2][2][4][2];
#pragma unroll
    for (int a = 0; a < 2; ++a)
#pragma unroll
        for (int b = 0; b < 2; ++b)
#pragma unroll
            for (int m = 0; m < 4; ++m)
#pragma unroll
                for (int n = 0; n < 2; ++n) acc[a][b][m][n] = (f32x4){0.f, 0.f, 0.f, 0.f};
    bf16x8 At[4][2], B0[2][2], B1[2][2];
    const char* cA = (const char*)g.A + (size_t)cur.pm * tstepA + (size_t)cur.ks * ksoff; const char* cB = (const char*)g.Bt + (size_t)cur.pn * tstepB + (size_t)cur.ks * ksoff;
    PG8_STAGE(PG8_SB(0, 0), cB, voffB); PG8_STAGE(PG8_SB(0, 1), cB + hstepB, voffB); PG8_STAGE(PG8_SA(0, 0), cA, voffA); PG8_STAGE(PG8_SA(0, 1), cA + hstepA, voffA);
    if (wr == 1) PG8_BAR;
    PG8_WAIT_V(2); PG8_BAR;
    PG8_STAGE(PG8_SB(1, 0), cB + kstep, voffB); PG8_STAGE(PG8_SA(1, 0), cA + kstep, voffA); PG8_STAGE(PG8_SB(1, 1), cB + hstepB + kstep, voffB);
    PG8_WAIT_V(6); PG8_BAR;
    for (;;) {
        const bool has_next = next_unit(g, ui + 1, nxt);
        const char* nA = has_next ? (const char*)g.A + (size_t)nxt.pm * tstepA + (size_t)nxt.ks * ksoff : cA;
        const char* nB = has_next ? (const char*)g.Bt + (size_t)nxt.pn * tstepB + (size_t)nxt.ks * ksoff : cB;
        for (int t = 0; t < nt; t += 2) {
            const bool last = (t == nt - 2);
            const char* a1 = cA + (size_t)(t + 1) * kstep;
            const char* a2 = last ? nA : cA + (size_t)(t + 2) * kstep; const char* b2 = last ? nB : cB + (size_t)(t + 2) * kstep;
            const char* a3 = a2 + kstep; const char* b3 = b2 + kstep;
            PG8_LDB(B0, 0, 0); PG8_LDB(B1, 0, 1); PG8_SCHED; PG8_LDA(At, 0, 0); PG8_STAGE(PG8_SA(1, 1), a1 + hstepA, voffA);
            PG8_WAIT_V(8); PG8_WAIT_L(0); PG8_BAR; PG8_MMA(0, 0, At, B0); PG8_MMA(0, 1, At, B1); PG8_BAR; PG8_SCHED;
            PG8_LDA(At, 0, 1); PG8_STAGE(PG8_SB(0, 0), b2, voffB); PG8_STAGE(PG8_SB(0, 1), b2 + hstepB, voffB); PG8_STAGE(PG8_SA(0, 0), a2, voffA);
            PG8_WAIT_V(8); PG8_WAIT_L(0); PG8_BAR; PG8_MMA(1, 0, At, B0); PG8_MMA(1, 1, At, B1); PG8_BAR; PG8_SCHED;
            PG8_LDB(B0, 1, 0); PG8_LDB(B1, 1, 1); PG8_SCHED; PG8_LDA(At, 1, 0); PG8_STAGE(PG8_SA(0, 1), a2 + hstepA, voffA);
            PG8_WAIT_V(8); PG8_WAIT_L(0); PG8_BAR; PG8_MMA(0, 0, At, B0); PG8_MMA(0, 1, At, B1); PG8_BAR; PG8_SCHED;
            PG8_LDA(At, 1, 1); PG8_STAGE(PG8_SB(1, 0), b3, voffB); PG8_STAGE(PG8_SB(1, 1), b3 + hstepB, voffB); PG8_STAGE(PG8_SA(1, 0), a3, voffA);
            PG8_WAIT_V(8); PG8_WAIT_L(0); PG8_BAR; PG8_MMA(1, 0, At, B0); PG8_MMA(1, 1, At, B1); PG8_BAR; PG8_SCHED;
        }
        if (wr == 0) PG8_BAR;
        E(acc, cur, wr, wc, fr, fq);
        if (!has_next) break;
#pragma unroll
        for (int a = 0; a < 2; ++a)
#pragma unroll
            for (int b = 0; b < 2; ++b)
#pragma unroll
                for (int m = 0; m < 4; ++m)
#pragma unroll
                    for (int n = 0; n < 2; ++n) acc[a][b][m][n] = (f32x4){0.f, 0.f, 0.f, 0.f};
        cur = nxt; cA = nA; cB = nB; ++ui;
        if (wr == 1) PG8_BAR;
    }
    PG8_WAIT_V(0);
    PG8_BAR;
#undef PG8_SA
#undef PG8_SB
#undef PG8_STAGE
#undef PG8_LDA
#undef PG8_LDB
#undef PG8_MMA
#undef PG8_WAIT_V
#undef PG8_WAIT_L
#undef PG8_BAR
#undef PG8_SCHED
}

template <int MODE, int ACT> struct EpiScaleBf16 {
    static constexpr bool PERM = true;
    bf16_t* O; int ldc; const float* rs;
    __device__ __forceinline__ void operator()(const f32x4 (&acc)[2][2][4][2], const Unit& u, int wr, int wc, int fr, int fq) const {
        const int row0 = u.pm * BM + wr * 64 + fr, col0 = u.pn * BM + wc * 32 + 8 * fq;
#pragma unroll
        for (int ai = 0; ai < 2; ++ai)
#pragma unroll
            for (int m = 0; m < 4; ++m) {
                const int row = row0 + ai * HALF + m * 16;
                float s = rs[row]; if (MODE == 1) s = rsqrtf(s * (1.0f / 2048.0f) + EPS);
                bf16_t* rowp = O + (size_t)row * ldc + col0;
#pragma unroll
                for (int bj = 0; bj < 2; ++bj) {
                    f32x4 v0 = acc[ai][bj][m][0] * s, v1 = acc[ai][bj][m][1] * s;
                    if (ACT == 1) {
#pragma unroll
                        for (int e = 0; e < 4; ++e) { float a = fmaxf(v0[e], 0.f), b = fmaxf(v1[e], 0.f); v0[e] = a * a; v1[e] = b * b; }
                    }
                    u32x4 w; w.x = pk2(v0[0], v0[1]); w.y = pk2(v0[2], v0[3]); w.z = pk2(v1[0], v1[1]); w.w = pk2(v1[2], v1[3]);
                    *(u32x4*)(rowp + bj * HALF) = w;
                }
            }
    }
};
template <int MODE> struct EpiResid {
    static constexpr bool PERM = false;
    const float* basef; const bf16_t* baseb; float* out; bf16_t* outb; float* sumsq;
    __device__ __forceinline__ void operator()(const f32x4 (&acc)[2][2][4][2], const Unit& u, int wr, int wc, int fr, int fq) const {
        const int row0 = u.pm * BM + wr * 64 + fr, col0 = u.pn * BM + wc * 32 + 4 * fq;
#pragma unroll
        for (int ai = 0; ai < 2; ++ai)
#pragma unroll
            for (int m = 0; m < 4; ++m) {
                const int row = row0 + ai * HALF + m * 16; const size_t off = (size_t)row * DM + col0; float ss = 0.f;
#pragma unroll
                for (int bj = 0; bj < 2; ++bj)
#pragma unroll
                    for (int n = 0; n < 2; ++n) {
                        f32x4 bs;
                        if (MODE == 0) bs = *(const f32x4*)(basef + off + bj * HALF + n * 16);
                        else { const u32x2 bw = *(const u32x2*)(baseb + off + bj * HALF + n * 16); bs = (f32x4){bflo(bw.x), bfhi(bw.x), bflo(bw.y), bfhi(bw.y)}; }
                        const f32x4 o = bs + acc[ai][bj][m][n];
                        if (MODE == 2) *(f32x4*)(out + off + bj * HALF + n * 16) = o;
                        else { u32x2 w; w.x = pk2(o[0], o[1]); w.y = pk2(o[2], o[3]); *(u32x2*)(outb + off + bj * HALF + n * 16) = w;
                            ss += (o[0] * o[0] + o[1] * o[1]) + (o[2] * o[2] + o[3] * o[3]); }
                    }
                if (MODE != 2) { ss += __shfl_xor(ss, 16); ss += __shfl_xor(ss, 32); if (fq == 0) atomicAdd(sumsq + row, ss); }
            }
    }
};
struct EpiPart {
    static constexpr bool PERM = false;
    float* part; int ldc; size_t ks_stride;
    __device__ __forceinline__ void operator()(const f32x4 (&acc)[2][2][4][2], const Unit& u, int wr, int wc, int fr, int fq) const {
        const int row0 = u.pm * BM + wr * 64 + fr, col0 = u.pn * BM + wc * 32 + 4 * fq; float* pb = part + (size_t)u.ks * ks_stride;
#pragma unroll
        for (int ai = 0; ai < 2; ++ai)
#pragma unroll
            for (int m = 0; m < 4; ++m) { const size_t off = (size_t)(row0 + ai * HALF + m * 16) * ldc + col0;
#pragma unroll
                for (int bj = 0; bj < 2; ++bj)
#pragma unroll
                    for (int n = 0; n < 2; ++n) *(f32x4*)(pb + off + bj * HALF + n * 16) = acc[ai][bj][m][n]; }
    }
};
struct EpiPartBf16 {
    static constexpr bool PERM = true;
    bf16_t* part; int ldc; size_t ks_stride;
    __device__ __forceinline__ void operator()(const f32x4 (&acc)[2][2][4][2], const Unit& u, int wr, int wc, int fr, int fq) const {
        const int row0 = u.pm * BM + wr * 64 + fr, col0 = u.pn * BM + wc * 32 + 8 * fq; bf16_t* pb = part + (size_t)u.ks * ks_stride;
#pragma unroll
        for (int ai = 0; ai < 2; ++ai)
#pragma unroll
            for (int m = 0; m < 4; ++m) { bf16_t* rowp = pb + (size_t)(row0 + ai * HALF + m * 16) * ldc + col0;
#pragma unroll
                for (int bj = 0; bj < 2; ++bj) { const f32x4 v0 = acc[ai][bj][m][0], v1 = acc[ai][bj][m][1];
                    u32x4 w; w.x = pk2(v0[0], v0[1]); w.y = pk2(v0[2], v0[3]); w.z = pk2(v1[0], v1[1]); w.w = pk2(v1[2], v1[3]); *(u32x4*)(rowp + bj * HALF) = w; } }
    }
};
}

struct Args {
    const float* in[25]; float* out; unsigned char* ws; int lo, hi;
};

__device__ __forceinline__ void p0_transpose_item(const float* __restrict__ W, int K, int N, bf16_t* __restrict__ WT, const float* __restrict__ gain, LAS float* scr, int k0, int n0, int drow0, int lane) {
    f32x4 v[16]; const int kr = lane >> 4, n4 = (lane & 15) * 4;
#pragma unroll
    for (int i = 0; i < 16; ++i) v[i] = __builtin_nontemporal_load((const f32x4*)(W + (size_t)(k0 + 4 * i + kr) * N + n0 + n4));
#pragma unroll
    for (int i = 0; i < 16; ++i) { const int kk = 4 * i + kr; const float g = gain ? gain[k0 + kk] : 1.0f; LAS float* d = scr + kk * 65 + n4;
        d[0] = v[i][0] * g; d[1] = v[i][1] * g; d[2] = v[i][2] * g; d[3] = v[i][3] * g; }
    asm volatile("s_waitcnt lgkmcnt(0)" ::: "memory");
    const int c = lane & 7;
#pragma unroll
    for (int j = 0; j < 8; ++j) { const int n = (lane >> 3) + 8 * j; const LAS float* s = scr + (8 * c) * 65 + n;
        u32x4 o; o.x = pk2(s[0 * 65], s[1 * 65]); o.y = pk2(s[2 * 65], s[3 * 65]); o.z = pk2(s[4 * 65], s[5 * 65]); o.w = pk2(s[6 * 65], s[7 * 65]);
        *(u32x4*)(WT + (size_t)(drow0 + n) * K + k0 + 8 * c) = o; }
    asm volatile("s_waitcnt lgkmcnt(0)" ::: "memory");
}
__device__ __forceinline__ bool p0_mat(int& r, const float* W, int K, int N, int ncols, bf16_t* WT, const float* gain, bool win_map, LAS float* scr, int lane) {
    const int nblk = ncols / 64, items = (K / 64) * nblk;
    if (r >= items) { r -= items; return false; }
    const int kb = r / nblk, nb = r % nblk, n0 = 64 * nb; int drow0 = n0;
    if (win_map) { const int seg = n0 >> 10; const int dseg = (seg == 1) ? 2 : (seg == 2) ? 3 : (seg == 3) ? 1 : seg; drow0 = dseg * 1024 + (n0 & 1023); }
    p0_transpose_item(W, K, N, WT, gain, scr, 64 * kb, n0, drow0, lane);
    return true;
}
__device__ __forceinline__ void p0_prologue(const Args& a, LAS unsigned char* lds) {
    const int tid = threadIdx.x, lane = tid & 63, wave = tid >> 6, G = gridDim.x;
    const int gw = blockIdx.x * 8 + wave, NGW = G * 8;
    unsigned char* ws = a.ws;
    LAS float* scr = (LAS float*)(lds + wave * 16640);
    constexpr int I_IN = 32 * 96, I_OUT = 32 * 32, I_CQ = 32 * 8, I_CKV = 32 * 16, I_CO = 8 * 32, I_UP = 32 * 128, I_DN = 128 * 32;
    constexpr int NITEMS = I_IN + I_OUT + I_CQ + I_CKV + I_CO + I_UP;
    for (int it = gw; it < NITEMS; it += NGW) {
        int r = it;
        if (p0_mat(r, a.in[4], DM, DIN, NPROJ, (bf16_t*)(ws + WS_WIN), a.in[3], true, scr, lane)) continue;
        if (p0_mat(r, a.in[14], DM, DM, DM, (bf16_t*)(ws + WS_WOUT), nullptr, false, scr, lane)) continue;
        if (p0_mat(r, a.in[17], DM, DCROSS, DCROSS, (bf16_t*)(ws + WS_WCQ), a.in[15], false, scr, lane)) continue;
        if (p0_mat(r, a.in[18], DM, 2 * DCROSS, 2 * DCROSS, (bf16_t*)(ws + WS_WCKV), a.in[16], false, scr, lane)) continue;
        if (p0_mat(r, a.in[21], DCROSS, DM, DM, (bf16_t*)(ws + WS_WCO), nullptr, false, scr, lane)) continue;
        p0_mat(r, a.in[23], DM, DFF, DFF, (bf16_t*)(ws + WS_WUP), a.in[22], false, scr, lane);
    }
    { float* z = (float*)(ws + WS_SUMSQ1); for (int i = blockIdx.x * 512 + tid; i < 2 * MTOK; i += G * 512) z[i] = 0.f; }
    __syncthreads();
    LAS float* wdt = (LAS float*)lds;
    { const float* win = a.in[4]; const float* gm = a.in[3];
      for (int k = tid; k < DM; k += 512) { const int i = k >> 8, l = (k & 255) >> 2, c = k & 3, s = (4 * i + c) * 64 + l; const float g = gm[k];
#pragma unroll
          for (int jc = 0; jc < 4; ++jc) { f32x4 w = *(const f32x4*)(win + (size_t)k * DIN + NPROJ + 4 * jc); w = w * g; *(LAS f32x4*)(wdt + s * 16 + 4 * (jc ^ ((l >> 2) & 3))) = w; } } }
    __syncthreads();
    const float* x = a.in[0]; const float* dtb = a.in[10];
    bf16_t* xb = (bf16_t*)(ws + WS_XB); float* rstd0 = (float*)(ws + WS_RSTD0); float* dtv = (float*)(ws + WS_DT);
    for (int row = gw; row < MTOK; row += NGW) {
        const f32x4* xr = (const f32x4*)(x + (size_t)row * DM) + lane;
        f32x4 v[8]; float ss = 0.f;
#pragma unroll
        for (int i = 0; i < 8; ++i) { v[i] = __builtin_nontemporal_load(xr + 64 * i); ss += (v[i][0] * v[i][0] + v[i][1] * v[i][1]) + (v[i][2] * v[i][2] + v[i][3] * v[i][3]); }
        ss = wave_sum(ss); const float rstd = rsqrtf(ss * (1.0f / DM) + EPS);
        u32x2* o8 = (u32x2*)(xb + (size_t)row * DM) + lane;
#pragma unroll
        for (int i = 0; i < 8; ++i) { u32x2 w; w.x = pk2(v[i][0], v[i][1]); w.y = pk2(v[i][2], v[i][3]); o8[64 * i] = w; }
        float acc[16];
        { f32x2 acc2[8];
#pragma unroll
          for (int j = 0; j < 8; ++j) acc2[j] = (f32x2){0.f, 0.f};
#pragma unroll
          for (int i = 0; i < 8; ++i)
#pragma unroll
              for (int c = 0; c < 4; ++c) { const LAS float* wp = wdt + ((4 * i + c) * 64 + lane) * 16; const f32x2 xv2 = (f32x2){v[i][c], v[i][c]};
#pragma unroll
                  for (int jc = 0; jc < 4; ++jc) { const f32x4 w = *(const LAS f32x4*)(wp + 4 * (jc ^ ((lane >> 2) & 3)));
                      acc2[2 * jc] = xv2 * (f32x2){w[0], w[1]} + acc2[2 * jc]; acc2[2 * jc + 1] = xv2 * (f32x2){w[2], w[3]} + acc2[2 * jc + 1]; } }
#pragma unroll
          for (int j = 0; j < 8; ++j) { acc[2 * j] = acc2[j].x; acc[2 * j + 1] = acc2[j].y; } }
        float a8[8], a4[4], a2[2], a1;
#pragma unroll
        for (int j = 0; j < 8; ++j) { const bool up = (lane & 32) != 0; const float mn = up ? acc[j + 8] : acc[j], ot = up ? acc[j] : acc[j + 8]; a8[j] = mn + __shfl_xor(ot, 32); }
#pragma unroll
        for (int j = 0; j < 4; ++j) { const bool up = (lane & 16) != 0; const float mn = up ? a8[j + 4] : a8[j], ot = up ? a8[j] : a8[j + 4]; a4[j] = mn + __shfl_xor(ot, 16); }
#pragma unroll
        for (int j = 0; j < 2; ++j) { const bool up = (lane & 8) != 0; const float mn = up ? a4[j + 2] : a4[j], ot = up ? a4[j] : a4[j + 2]; a2[j] = mn + __shfl_xor(ot, 8); }
        { const bool up = (lane & 4) != 0; const float mn = up ? a2[1] : a2[0], ot = up ? a2[0] : a2[1]; a1 = mn + __shfl_xor(ot, 4); }
        a1 += __shfl_xor(a1, 2); a1 += __shfl_xor(a1, 1);
        if ((lane & 3) == 0) { const int j = lane >> 2; const float xr2 = rstd * a1 + dtb[j]; dtv[(size_t)row * 16 + j] = (xr2 > 20.f) ? xr2 : log1pf(expf(xr2)); }
        if (lane == 0) rstd0[row] = rstd;
    }
    const float* mem = a.in[1]; bf16_t* memb = (bf16_t*)(ws + WS_MEMB); float* rstdm = (float*)(ws + WS_RSTDM);
    for (int row = gw; row < MMEM; row += NGW) {
        const f32x4* xr = (const f32x4*)(mem + (size_t)row * DM) + lane;
        f32x4 v[8]; float ss = 0.f;
#pragma unroll
        for (int i = 0; i < 8; ++i) { v[i] = __builtin_nontemporal_load(xr + 64 * i); ss += (v[i][0] * v[i][0] + v[i][1] * v[i][1]) + (v[i][2] * v[i][2] + v[i][3] * v[i][3]); }
        ss = wave_sum(ss);
        u32x2* o8 = (u32x2*)(memb + (size_t)row * DM) + lane;
#pragma unroll
        for (int i = 0; i < 8; ++i) { u32x2 w; w.x = pk2(v[i][0], v[i][1]); w.y = pk2(v[i][2], v[i][3]); o8[64 * i] = w; }
        if (lane == 0) rstdm[row] = rsqrtf(ss * (1.0f / DM) + EPS);
    }
}

__device__ __forceinline__ void p2_qkprep(const Args& a) {
    bf16_t* proj = (bf16_t*)(a.ws + WS_PROJ); const int* pos = (const int*)a.in[2];
    const int gl = blockIdx.x * 512 + threadIdx.x, sub = gl & 7, NIT = (gridDim.x * 512) >> 3;
    float invf[8];
#pragma unroll
    for (int j = 0; j < 8; ++j) invf[j] = __expf(-(float)j * 0.125f * 13.122363377404328f);
    for (int item0 = gl >> 3; item0 < 2 * MTOK * 16; item0 += 4 * NIT) {
        u32x4 w[4]; bf16_t* p[4]; int mm[4], wh[4];
#pragma unroll
        for (int q = 0; q < 4; ++q) { int item = item0 + q * NIT; if (item >= 2 * MTOK * 16) item = item0;
            const int h = item & 15; mm[q] = (item >> 4) & (MTOK - 1); wh[q] = item >> 17;
            p[q] = proj + (size_t)mm[q] * NPROJ + (wh[q] ? PC_K : PC_Q) + h * 64 + 8 * sub; w[q] = *(const u32x4*)p[q]; }
#pragma unroll
        for (int q = 0; q < 4; ++q) {
            const float* gn = (wh[q] ? a.in[6] : a.in[5]) + 8 * sub;
            float v[8] = {bflo(w[q].x), bfhi(w[q].x), bflo(w[q].y), bfhi(w[q].y), bflo(w[q].z), bfhi(w[q].z), bflo(w[q].w), bfhi(w[q].w)};
            float ss = 0.f;
#pragma unroll
            for (int j = 0; j < 8; ++j) ss += v[j] * v[j];
            ss += __shfl_xor(ss, 1); ss += __shfl_xor(ss, 2); ss += __shfl_xor(ss, 4);
            const float rstd = rsqrtf(ss * (1.0f / 64.0f) + EPS);
            const f32x4 g0 = *(const f32x4*)gn, g1 = *(const f32x4*)(gn + 4);
            v[0] *= rstd * g0[0]; v[1] *= rstd * g0[1]; v[2] *= rstd * g0[2]; v[3] *= rstd * g0[3]; v[4] *= rstd * g1[0]; v[5] *= rstd * g1[1]; v[6] *= rstd * g1[2]; v[7] *= rstd * g1[3];
            const float fp = (float)pos[mm[q]];
#pragma unroll
            for (int j = 0; j < 8; ++j) {
                const float other = __shfl_xor(v[j], 1);
                if (sub < 2) {
                    const float ang = fp * invf[j]; const float n = rintf(ang * 0.15915494309189535f);
                    float r = fmaf(-n, 6.2831854820251465f, ang); r = fmaf(-n, -1.7484555e-7f, r);
                    const float sn = __sinf(r), cs = __cosf(r);
                    v[j] = (sub == 0) ? (v[j] * cs - other * sn) : (v[j] * cs + other * sn);
                }
            }
            const float sc = wh[q] ? 1.0f : 0.125f;
            u32x4 o; o.x = pk2(v[0] * sc, v[1] * sc); o.y = pk2(v[2] * sc, v[3] * sc); o.z = pk2(v[4] * sc, v[5] * sc); o.w = pk2(v[6] * sc, v[7] * sc);
            if (item0 + q * NIT < 2 * MTOK * 16) *(u32x4*)p[q] = o;
        }
    }
}

constexpr int SROW = 272;
constexpr int L_XT = 0, L_B = 69632, L_C = 104448, L_F32 = 139264, L_RED = L_F32 + 6144;
__device__ __forceinline__ void ssd_dt(LAS float* f32a, const float* dtbuf, const float* a_log, int m0, int g) {
    const int tid = threadIdx.x, hh = tid >> 7, t = tid & 127;
    LAS float* dA = f32a; LAS float* acs = f32a + 512; LAS float* dtv = f32a + 1024;
    const float dt = dtbuf[(size_t)(m0 + t) * 16 + g * 4 + hh];
    const float av = -__expf(a_log[g * 4 + hh]);
    dtv[hh * 128 + t] = dt; dA[hh * 128 + t] = dt * av;
    __syncthreads();
    const int seg = t >> 4;
    float s = 0.f;
    for (int u = 16 * seg; u <= t; ++u) s += dA[hh * 128 + u];
    acs[hh * 128 + t] = s;
    __syncthreads();
    float add = 0.f;
    for (int k = 0; k < seg; ++k) add += acs[hh * 128 + 16 * k + 15];
    __syncthreads();
    acs[hh * 128 + t] = s + add;
    __syncthreads();
}
__device__ __forceinline__ int swz(int row) { return ((row >> 3) & 15) << 3; }
template <int MODE>
__device__ __forceinline__ void ssd_build(LAS unsigned char* lds, const bf16_t* proj, const float* conv_w, const float* conv_b, int c, int m0, int g, const LAS float* wgt) {
    const int tid = threadIdx.x, ch = tid & 63, s0 = (tid >> 6) * 16;
    if (MODE == 0 && ch >= 48) return;
    const int cb = (ch < 32) ? (g * 256 + ch * 8) : (ch < 48) ? (1024 + g * 128 + (ch - 32) * 8) : (1536 + g * 128 + (ch - 48) * 8);
    f32x2 cw2[4][4], bias2[4];
#pragma unroll
    for (int w = 0; w < 4; ++w) { const f32x4 w0 = *(const f32x4*)(conv_w + w * 2048 + cb), w1 = *(const f32x4*)(conv_w + w * 2048 + cb + 4);
        cw2[w][0] = (f32x2){w0[0], w0[1]}; cw2[w][1] = (f32x2){w0[2], w0[3]}; cw2[w][2] = (f32x2){w1[0], w1[1]}; cw2[w][3] = (f32x2){w1[2], w1[3]}; }
    { const f32x4 b0 = *(const f32x4*)(conv_b + cb), b1 = *(const f32x4*)(conv_b + cb + 4);
      bias2[0] = (f32x2){b0[0], b0[1]}; bias2[1] = (f32x2){b0[2], b0[3]}; bias2[2] = (f32x2){b1[0], b1[1]}; bias2[3] = (f32x2){b1[2], b1[3]}; }
#pragma unroll 1
    for (int half = 0; half < 2; ++half) {
        const int sh = s0 + 8 * half;
        const bf16_t* src = proj + (size_t)(m0 + sh) * NPROJ + PC_X + cb;
        u32x4 raw[11];
#pragma unroll
        for (int i = 0; i < 11; ++i) { const int tpos = c * 128 + sh - 3 + i; raw[i] = (tpos >= 0) ? *(const u32x4*)(src + (ptrdiff_t)(i - 3) * NPROJ) : (u32x4){0u, 0u, 0u, 0u}; }
        f32x2 win2[4][4];
#pragma unroll
        for (int i = 0; i < 3; ++i) { win2[i][0] = (f32x2){bflo(raw[i].x), bfhi(raw[i].x)}; win2[i][1] = (f32x2){bflo(raw[i].y), bfhi(raw[i].y)};
            win2[i][2] = (f32x2){bflo(raw[i].z), bfhi(raw[i].z)}; win2[i][3] = (f32x2){bflo(raw[i].w), bfhi(raw[i].w)}; }
#pragma unroll
        for (int t = 0; t < 8; ++t) {
            const int s = sh + t; const int cur = (t + 3) & 3;
            win2[cur][0] = (f32x2){bflo(raw[t + 3].x), bfhi(raw[t + 3].x)}; win2[cur][1] = (f32x2){bflo(raw[t + 3].y), bfhi(raw[t + 3].y)};
            win2[cur][2] = (f32x2){bflo(raw[t + 3].z), bfhi(raw[t + 3].z)}; win2[cur][3] = (f32x2){bflo(raw[t + 3].w), bfhi(raw[t + 3].w)};
            float acc[8];
#pragma unroll
            for (int i = 0; i < 4; ++i) { f32x2 v = bias2[i];
#pragma unroll
                for (int w = 0; w < 4; ++w) v = cw2[w][i] * win2[(t + w) & 3][i] + v;
                const f32x2 ng = v * (-1.4426950408889634f); f32x2 d; d.x = __builtin_amdgcn_exp2f(ng.x); d.y = __builtin_amdgcn_exp2f(ng.y); d = d + 1.0f;
                f32x2 rc; rc.x = __builtin_amdgcn_rcpf(d.x); rc.y = __builtin_amdgcn_rcpf(d.y); const f32x2 o = v * rc;
                acc[2 * i] = o.x; acc[2 * i + 1] = o.y; }
            if (ch < 32) {
                const int hh = ch >> 3; float sc = 1.0f; if (MODE == 0) sc = wgt[hh * 128 + s];
                const int col = s ^ swz(ch * 8);
#pragma unroll
                for (int e = 0; e < 8; e += 2) { const unsigned w = pk2(acc[e] * sc, acc[e + 1] * sc);
                    *(LAS unsigned short*)(lds + L_XT + (ch * 8 + e) * SROW + col * 2) = (unsigned short)(w & 0xffffu);
                    *(LAS unsigned short*)(lds + L_XT + (ch * 8 + e + 1) * SROW + col * 2) = (unsigned short)(w >> 16); }
            } else if (MODE == 0) {
                const int col = s ^ swz((ch - 32) * 8);
#pragma unroll
                for (int e = 0; e < 8; e += 2) { const unsigned w = pk2(acc[e], acc[e + 1]);
                    *(LAS unsigned short*)(lds + L_B + ((ch - 32) * 8 + e) * SROW + col * 2) = (unsigned short)(w & 0xffffu);
                    *(LAS unsigned short*)(lds + L_B + ((ch - 32) * 8 + e + 1) * SROW + col * 2) = (unsigned short)(w >> 16); }
            } else {
                u32x4 w; w.x = pk2(acc[0], acc[1]); w.y = pk2(acc[2], acc[3]); w.z = pk2(acc[4], acc[5]); w.w = pk2(acc[6], acc[7]);
                const int off = (ch < 48) ? (L_B + s * SROW + (ch - 32) * 16) : (L_C + s * SROW + (ch - 48) * 16);
                *(LAS u32x4*)(lds + off) = w;
            }
        }
    }
}

__device__ __forceinline__ void p2_ssd_states(const Args& a, LAS unsigned char* lds) {
    const int tid = threadIdx.x, lane = tid & 63, wid = tid >> 6, l31 = lane & 31, hi = lane >> 5;
    const bf16_t* proj = (const bf16_t*)(a.ws + WS_PROJ); const float* dtbuf = (const float*)(a.ws + WS_DT);
    float* states = (float*)(a.ws + WS_STATES); float* atot = (float*)(a.ws + WS_ATOT);
    LAS float* f32a = (LAS float*)(lds + L_C);
    for (int unit = blockIdx.x; unit < 256; unit += gridDim.x) {
        const int g = unit & 3, c = (unit >> 2) & 15, b = unit >> 6, m0 = b * SEQ + c * 128;
        __syncthreads();
        ssd_dt(f32a, dtbuf, a.in[11], m0, g);
        { const int hh = tid >> 7, t = tid & 127; const float at = f32a[512 + hh * 128 + 127];
          f32a[1536 + hh * 128 + t] = __expf(at - f32a[512 + hh * 128 + t]) * f32a[1024 + hh * 128 + t];
          if (t == 127) atot[(b * 16 + c) * 16 + g * 4 + hh] = at; }
        __syncthreads();
        ssd_build<0>(lds, proj, a.in[8], a.in[9], c, m0, g, f32a + 1536);
        __syncthreads();
        const int hh = wid >> 1, pb = wid & 1;
        f32x16 acc[4];
#pragma unroll
        for (int nb = 0; nb < 4; ++nb) acc[nb] = zero16();
#pragma unroll
        for (int ks = 0; ks < 8; ++ks) {
            const bf16x8 af = *(const LAS bf16x8*)(lds + L_XT + (hh * 64 + 32 * pb + l31) * SROW + ((16 * ks + 8 * hi) ^ swz(hh * 64 + 32 * pb + l31)) * 2);
#pragma unroll
            for (int nb = 0; nb < 4; ++nb) { const bf16x8 bf = *(const LAS bf16x8*)(lds + L_B + (32 * nb + l31) * SROW + ((16 * ks + 8 * hi) ^ swz(32 * nb + l31)) * 2); acc[nb] = MFMA32(af, bf, acc[nb]); }
        }
        float* st = states + (size_t)((b * 16 + c) * 16 + g * 4 + hh) * 8192;
#pragma unroll
        for (int nb = 0; nb < 4; ++nb)
#pragma unroll
            for (int r = 0; r < 16; ++r) { const int p = 32 * pb + (r & 3) + 8 * (r >> 2) + 4 * hi; st[p * 128 + 32 * nb + l31] = acc[nb][r]; }
    }
}

__device__ __forceinline__ void p3_scan(const Args& a) {
    const int tid = threadIdx.x, lane = tid & 63, wid = tid >> 6;
    const float* states = (const float*)(a.ws + WS_STATES); const float* atot = (const float*)(a.ws + WS_ATOT); bf16_t* prevb = (bf16_t*)a.out;
    const int gw = blockIdx.x * 8 + wid, NGW = gridDim.x * 8;
    for (int it = gw; it < 2048; it += NGW) {
        const int b = it >> 9, head = (it >> 5) & 15, prp = it & 31; const size_t eoff = (size_t)prp * 256 + lane * 4;
        f32x4 s[16]; float dec[16];
#pragma unroll
        for (int c = 0; c < 16; ++c) { s[c] = *(const f32x4*)(states + (size_t)((b * 16 + c) * 16 + head) * 8192 + eoff); dec[c] = __expf(atot[(b * 16 + c) * 16 + head]); }
        f32x4 h = (f32x4){0.f, 0.f, 0.f, 0.f};
#pragma unroll
        for (int c = 0; c < 16; ++c) { u32x2 w; w.x = pk2(h[0], h[1]); w.y = pk2(h[2], h[3]);
            *(u32x2*)(prevb + (size_t)((b * 16 + c) * 16 + head) * 8192 + eoff) = w; h = h * dec[c] + s[c]; }
    }
}

__device__ __forceinline__ void p3_ssd_out(const Args& a, LAS unsigned char* lds) {
    const int tid = threadIdx.x, lane = tid & 63, wid = tid >> 6, l31 = lane & 31, hi = lane >> 5;
    bf16_t* proj = (bf16_t*)(a.ws + WS_PROJ); const float* dtbuf = (const float*)(a.ws + WS_DT);
    const bf16_t* prevb = (const bf16_t*)a.out;
    LAS float* f32a = (LAS float*)(lds + L_F32); LAS float* acs = f32a + 512; LAS float* dtl = f32a + 1024; LAS float* red = (LAS float*)(lds + L_RED);
    for (int unit = blockIdx.x; unit < 256; unit += gridDim.x) {
        const int g = unit & 3, c = (unit >> 2) & 15, b = unit >> 6, m0 = b * SEQ + c * 128;
        __syncthreads();
        ssd_dt(f32a, dtbuf, a.in[11], m0, g);
        ssd_build<1>(lds, proj, a.in[8], a.in[9], c, m0, g, nullptr);
        __syncthreads();
        const int hh = wid >> 1, pb = wid & 1, head = g * 4 + hh, prow = 32 * pb + l31;
        bf16x8 pf[8];
        { const bf16_t* pp = prevb + (size_t)((b * 16 + c) * 16 + head) * 8192 + prow * 128 + 8 * hi;
#pragma unroll
          for (int ks = 0; ks < 8; ++ks) pf[ks] = *(const bf16x8*)(pp + 16 * ks); }
        const float dsk = a.in[12][head];
        u32x2 zw[4][4];
#pragma unroll
        for (int lb = 0; lb < 4; ++lb) { const bf16_t* zrow = proj + (size_t)(m0 + 32 * lb + l31) * NPROJ + PC_Z + head * 64 + 32 * pb + 4 * hi;
#pragma unroll
            for (int rg = 0; rg < 4; ++rg) zw[lb][rg] = *(const u32x2*)(zrow + 8 * rg); }
        f32x16 y[4];
#pragma unroll
        for (int lb = 0; lb < 4; ++lb) {
            bf16x8 cf[8];
#pragma unroll
            for (int ks = 0; ks < 8; ++ks) cf[ks] = *(const LAS bf16x8*)(lds + L_C + (32 * lb + l31) * SROW + (16 * ks + 8 * hi) * 2);
            f32x16 acc = zero16();
#pragma unroll
            for (int ks = 0; ks < 8; ++ks) acc = MFMA32(pf[ks], cf[ks], acc);
            const int l = 32 * lb + l31; const float al = acs[hh * 128 + l]; const float el = __expf(al);
#pragma unroll
            for (int r = 0; r < 16; ++r) acc[r] *= el;
            for (int sb = 0; sb <= lb; ++sb) {
                f32x16 cbt = zero16();
#pragma unroll
                for (int ks = 0; ks < 8; ++ks) { const bf16x8 bfr = *(const LAS bf16x8*)(lds + L_B + (32 * sb + l31) * SROW + (16 * ks + 8 * hi) * 2); cbt = MFMA32(bfr, cf[ks], cbt); }
                float wv[16];
#pragma unroll
                for (int rg = 0; rg < 4; ++rg) { const int s0 = 32 * sb + 8 * rg + 4 * hi;
                    const f32x4 as4 = *(const LAS f32x4*)(acs + hh * 128 + s0), dt4 = *(const LAS f32x4*)(dtl + hh * 128 + s0);
#pragma unroll
                    for (int e = 0; e < 4; ++e) { const float v = cbt[4 * rg + e] * __expf(al - as4[e]) * dt4[e]; wv[4 * rg + e] = (s0 + e <= l) ? v : 0.f; } }
                const bf16x8 w0 = pack8(wv[0], wv[1], wv[2], wv[3], wv[4], wv[5], wv[6], wv[7]);
                const bf16x8 w1 = pack8(wv[8], wv[9], wv[10], wv[11], wv[12], wv[13], wv[14], wv[15]);
                const LAS unsigned char* xrowb = lds + L_XT + (hh * 64 + prow) * SROW; const int xs_ = swz(hh * 64 + prow), c0_ = 32 * sb + 4 * hi;
                { const s16x4 lo = *(const LAS s16x4*)(xrowb + ((c0_) ^ xs_) * 2), hi4 = *(const LAS s16x4*)(xrowb + ((c0_ + 8) ^ xs_) * 2);
                  bf16x8 af; af[0] = lo[0]; af[1] = lo[1]; af[2] = lo[2]; af[3] = lo[3]; af[4] = hi4[0]; af[5] = hi4[1]; af[6] = hi4[2]; af[7] = hi4[3];
                  acc = MFMA32(af, w0, acc); }
                { const s16x4 lo = *(const LAS s16x4*)(xrowb + ((c0_ + 16) ^ xs_) * 2), hi4 = *(const LAS s16x4*)(xrowb + ((c0_ + 24) ^ xs_) * 2);
                  bf16x8 af; af[0] = lo[0]; af[1] = lo[1]; af[2] = lo[2]; af[3] = lo[3]; af[4] = hi4[0]; af[5] = hi4[1]; af[6] = hi4[2]; af[7] = hi4[3];
                  acc = MFMA32(af, w1, acc); }
            }
            float ss = 0.f;
#pragma unroll
            for (int rg = 0; rg < 4; ++rg) { const u32x2 zq = zw[lb][rg];
                const float zf[4] = {bflo(zq.x), bfhi(zq.x), bflo(zq.y), bfhi(zq.y)};
#pragma unroll
                for (int e = 0; e < 4; ++e) { const int p = 32 * pb + 8 * rg + 4 * hi + e;
                    const float xv = __uint_as_float((unsigned)(*(const LAS unsigned short*)(lds + L_XT + (hh * 64 + p) * SROW + (l ^ swz(hh * 64 + p)) * 2)) << 16);
                    float v = acc[4 * rg + e] + dsk * xv; v *= zf[e] * __builtin_amdgcn_rcpf(1.0f + __expf(-zf[e])); acc[4 * rg + e] = v; ss += v * v; } }
            ss += __shfl_xor(ss, 32);
            if (hi == 0) red[wid * 128 + l] = ss;
            y[lb] = acc;
        }
        __syncthreads();
        const float* gso = a.in[13] + head * 64 + 32 * pb + 4 * hi;
#pragma unroll
        for (int lb = 0; lb < 4; ++lb) { const int l = 32 * lb + l31; float tot = 0.f;
#pragma unroll
            for (int w = 0; w < 8; ++w) tot += red[w * 128 + l];
            const float rstd = rsqrtf(tot * (1.0f / 256.0f) + EPS);
            bf16_t* orow = proj + (size_t)(m0 + l) * NPROJ + PC_Z + head * 64 + 32 * pb + 4 * hi;
#pragma unroll
            for (int rg = 0; rg < 4; ++rg) { const f32x4 g4 = *(const f32x4*)(gso + 8 * rg);
                u32x2 w; w.x = pk2(y[lb][4 * rg] * rstd * g4[0], y[lb][4 * rg + 1] * rstd * g4[1]); w.y = pk2(y[lb][4 * rg + 2] * rstd * g4[2], y[lb][4 * rg + 3] * rstd * g4[3]);
                *(u32x2*)(orow + 8 * rg) = w; } }
    }
}

constexpr int AKROW = 144, AVROW = 784, LA_K = 0, LA_V = 384 * AKROW, ATT_UNITS = 3 * 512;
__device__ __forceinline__ int attn_row_token(int br, int blk, int j) {
    if (br == 0) { return 256 * blk - 128 + j; }
    if (br == 1) { const int idx = 256 * (blk & 1) - 128 + j; return idx < 0 ? -1 : (blk >> 1) + 4 * idx; }
    if (j >= 256) return -1;
    return 2 * blk + (j >> 7) + 16 * (j & 127);
}
__device__ __forceinline__ void attn_load(const bf16_t* proj, int u, u32x4 (&kr)[6], u32x4 (&vr)[6]) {
    const int tid = threadIdx.x, blk = u & 7, hd = (u >> 3) & 15, b = (u >> 7) & 3, br = u >> 9;
#pragma unroll
    for (int i = 0; i < 6; ++i) {
        const int c = tid + 512 * i;
        { const int j = c >> 3, cc = c & 7, t = attn_row_token(br, blk, j);
          kr[i] = (t >= 0) ? *(const u32x4*)(proj + ((size_t)b * SEQ + t) * NPROJ + PC_K + hd * 64 + cc * 8) : (u32x4){0u, 0u, 0u, 0u}; }
        { const int j = c >> 3, cc = c & 7, t = attn_row_token(br, blk, j);
          vr[i] = (t >= 0) ? *(const u32x4*)(proj + ((size_t)b * SEQ + t) * NPROJ + PC_V + hd * 64 + cc * 8) : (u32x4){0u, 0u, 0u, 0u}; }
    }
}
__device__ __forceinline__ void attn_store(LAS unsigned char* lds, const u32x4 (&kr)[6], const u32x4 (&vr)[6]) {
    const int tid = threadIdx.x;
#pragma unroll
    for (int i = 0; i < 6; ++i) {
        const int c = tid + 512 * i;
        { const int j = c >> 3, cc = c & 7; *(LAS u32x4*)(lds + LA_K + j * AKROW + cc * 16) = kr[i]; }
        { const int j = c >> 3, cc = c & 7, col = j ^ (8 * cc); const unsigned wv[4] = {vr[i].x, vr[i].y, vr[i].z, vr[i].w};
#pragma unroll
          for (int e = 0; e < 4; ++e) { *(LAS unsigned short*)(lds + LA_V + (cc * 8 + 2 * e) * AVROW + col * 2) = (unsigned short)(wv[e] & 0xffffu);
              *(LAS unsigned short*)(lds + LA_V + (cc * 8 + 2 * e + 1) * AVROW + col * 2) = (unsigned short)(wv[e] >> 16); } }
    }
}
__device__ __forceinline__ void p3_attn(const Args& a, LAS unsigned char* lds) {
    const int tid = threadIdx.x, lane = tid & 63, wid = tid >> 6, l31 = lane & 31, hi = lane >> 5;
    const bf16_t* proj = (const bf16_t*)(a.ws + WS_PROJ); bf16_t* obr = (bf16_t*)(a.ws + WS_OBR); float* lse = (float*)(a.ws + WS_LSE);
    unsigned* qctr = (unsigned*)(a.ws + WS_BAR) + 3584;
    const unsigned myx = ((unsigned)__builtin_amdgcn_s_getreg((3 << 11) | 20)) & 7u;
#define ATT_FETCH() do { unsigned got_ = (unsigned)ATT_UNITS; \
        for (unsigned t_ = 0; t_ < 8u; ++t_) { const unsigned xq_ = (myx + t_) & 7u; const unsigned i_ = atomicAdd(qctr + 64 * xq_, 1u); \
            if (i_ < 192u) { const unsigned p_ = xq_ + 8u * (i_ / 24u), sub_ = i_ % 24u; got_ = (sub_ >> 3) * 512u + p_ * 8u + (sub_ & 7u); break; } } \
        qnext[0] = got_; } while (0)
    volatile LAS unsigned* qnext = (volatile LAS unsigned*)(lds + LDS_BYTES - 32);
    u32x4 kr[6], vr[6];
    __syncthreads();
    if (tid == 0) ATT_FETCH();
    __syncthreads();
    int u = (int)qnext[0];
    bf16x8 qn[4];
#define ATT_GEOM(uu, tq_, rowt0_, kt0_) do { const int blk_ = (uu) & 7, br_ = (uu) >> 9; \
        if (br_ < 2) { const int base_q = (br_ == 0) ? 256 * blk_ : 256 * (blk_ & 1), r_ = (br_ == 0) ? 0 : (blk_ >> 1), d_ = (br_ == 0) ? 1 : 4; \
            tq_ = r_ + d_ * (base_q + 32 * wid + l31); rowt0_ = 32 * wid; const int q32 = (base_q >> 5) + wid; kt0_ = (q32 >= 4) ? 0 : 4 - q32; } \
        else { const int rsel = wid >> 2, wq = wid & 3; tq_ = 2 * blk_ + rsel + 16 * (32 * wq + l31); rowt0_ = 128 * rsel + 32 * wq - 128; kt0_ = 4 - wq; } } while (0)
#define ATT_QLOAD(uu) do { int tq_, r0_, k0_; ATT_GEOM(uu, tq_, r0_, k0_); (void)r0_; (void)k0_; const size_t mq_ = (size_t)(((uu) >> 7) & 3) * SEQ + tq_; \
        _Pragma("unroll") for (int kk = 0; kk < 4; ++kk) qn[kk] = *(const bf16x8*)(proj + mq_ * NPROJ + PC_Q + (((uu) >> 3) & 15) * 64 + 16 * kk + 8 * hi); } while (0)
    if (u < ATT_UNITS) { attn_load(proj, u, kr, vr); ATT_QLOAD(u); }
    while (u < ATT_UNITS) {
        __syncthreads();
        attn_store(lds, kr, vr);
        if (tid == 0) ATT_FETCH();
        __syncthreads();
        const int un = (int)qnext[0];
        bf16x8 qf[4];
#pragma unroll
        for (int kk = 0; kk < 4; ++kk) qf[kk] = qn[kk];
        if (un < ATT_UNITS) { attn_load(proj, un, kr, vr); ATT_QLOAD(un); }
        const int blk = u & 7, hd = (u >> 3) & 15, b = (u >> 7) & 3, br = u >> 9;
        int tq, rowt0, kt0; ATT_GEOM(u, tq, rowt0, kt0);
        const size_t mq = (size_t)b * SEQ + tq;
        float m_run = -INFINITY, l_run = 0.f; f32x16 acc[2]; acc[0] = zero16(); acc[1] = zero16();
        for (int kt = kt0; kt < 5; ++kt) {
            const int row0 = rowt0 + 32 * kt;
            f32x16 st = zero16();
#pragma unroll
            for (int kk = 0; kk < 4; ++kk) { const bf16x8 kf = *(const LAS bf16x8*)(lds + LA_K + (row0 + l31) * AKROW + (16 * kk + 8 * hi) * 2); st = MFMA32(kf, qf[kk], st); }
            const int dbase = 128 - 32 * kt + l31 - 4 * hi; float mx = -INFINITY;
#pragma unroll
            for (int rr = 0; rr < 16; ++rr) { const int dist = dbase - ((rr & 3) + 8 * (rr >> 2)); const bool ok = (dist >= 0) && (dist <= 128); st[rr] = ok ? st[rr] : -INFINITY; mx = fmaxf(mx, st[rr]); }
            mx = fmaxf(mx, __shfl_xor(mx, 32));
            const float m_new = fmaxf(m_run, mx), alpha = __expf(m_run - m_new); float psum = 0.f;
#pragma unroll
            for (int rr = 0; rr < 16; ++rr) { st[rr] = __expf(st[rr] - m_new); psum += st[rr]; }
            psum += __shfl_xor(psum, 32);
            l_run = l_run * alpha + psum; m_run = m_new;
#pragma unroll
            for (int rr = 0; rr < 16; ++rr) { acc[0][rr] *= alpha; acc[1][rr] *= alpha; }
            const bf16x8 p0 = pack8(st[0], st[1], st[2], st[3], st[4], st[5], st[6], st[7]);
            const bf16x8 p1 = pack8(st[8], st[9], st[10], st[11], st[12], st[13], st[14], st[15]);
#pragma unroll
            for (int db = 0; db < 2; ++db) {
                const LAS unsigned char* vrowb = lds + LA_V + (32 * db + l31) * AVROW; const int vsw = 8 * (((32 * db + l31) >> 3) & 7), vc0 = row0 + 4 * hi;
                { const s16x4 lo = *(const LAS s16x4*)(vrowb + ((vc0) ^ vsw) * 2), h4 = *(const LAS s16x4*)(vrowb + ((vc0 + 8) ^ vsw) * 2);
                  bf16x8 af; af[0] = lo[0]; af[1] = lo[1]; af[2] = lo[2]; af[3] = lo[3]; af[4] = h4[0]; af[5] = h4[1]; af[6] = h4[2]; af[7] = h4[3];
                  acc[db] = MFMA32(af, p0, acc[db]); }
                { const s16x4 lo = *(const LAS s16x4*)(vrowb + ((vc0 + 16) ^ vsw) * 2), h4 = *(const LAS s16x4*)(vrowb + ((vc0 + 24) ^ vsw) * 2);
                  bf16x8 af; af[0] = lo[0]; af[1] = lo[1]; af[2] = lo[2]; af[3] = lo[3]; af[4] = h4[0]; af[5] = h4[1]; af[6] = h4[2]; af[7] = h4[3];
                  acc[db] = MFMA32(af, p1, acc[db]); }
            }
        }
        const float inv = 1.0f / l_run;
        bf16_t* op = obr + ((size_t)br * MTOK + mq) * 1024 + hd * 64 + 4 * hi;
#pragma unroll
        for (int db = 0; db < 2; ++db)
#pragma unroll
            for (int rg = 0; rg < 4; ++rg) { u32x2 w; w.x = pk2(acc[db][4 * rg] * inv, acc[db][4 * rg + 1] * inv); w.y = pk2(acc[db][4 * rg + 2] * inv, acc[db][4 * rg + 3] * inv);
                *(u32x2*)(op + 32 * db + 8 * rg) = w; }
        if (hi == 0) lse[((size_t)br * MTOK + mq) * 16 + hd] = m_run + __logf(l_run);
        u = un;
    }
}

__device__ __forceinline__ void p4_combine(const Args& a) {
    const int tid = threadIdx.x, lane = tid & 63, wid = tid >> 6;
    bf16_t* proj = (bf16_t*)(a.ws + WS_PROJ); const bf16_t* obr = (const bf16_t*)(a.ws + WS_OBR); const float* lse = (const float*)(a.ws + WS_LSE);
    const float* gao = a.in[7];
    const int gw = blockIdx.x * 8 + wid, NGW = gridDim.x * 8;
    for (int m = gw; m < MTOK; m += NGW) {
        const int hd = lane >> 2;
        const float l0 = lse[((size_t)0 * MTOK + m) * 16 + hd], l1 = lse[((size_t)1 * MTOK + m) * 16 + hd], l2 = lse[((size_t)2 * MTOK + m) * 16 + hd];
        const float mx = fmaxf(l0, fmaxf(l1, l2)); const float e0 = __expf(l0 - mx), e1 = __expf(l1 - mx), e2 = __expf(l2 - mx); const float inv = 1.0f / (e0 + e1 + e2);
        const float wg[3] = {e0 * inv, e1 * inv, e2 * inv};
        float v[16];
#pragma unroll
        for (int e = 0; e < 16; ++e) v[e] = 0.f;
#pragma unroll
        for (int gI = 0; gI < 3; ++gI) { const bf16_t* p = obr + ((size_t)gI * MTOK + m) * 1024 + lane * 16;
#pragma unroll
            for (int c = 0; c < 2; ++c) { const u32x4 w = *(const u32x4*)(p + 8 * c);
                v[8 * c + 0] += wg[gI] * bflo(w.x); v[8 * c + 1] += wg[gI] * bfhi(w.x); v[8 * c + 2] += wg[gI] * bflo(w.y); v[8 * c + 3] += wg[gI] * bfhi(w.y);
                v[8 * c + 4] += wg[gI] * bflo(w.z); v[8 * c + 5] += wg[gI] * bfhi(w.z); v[8 * c + 6] += wg[gI] * bflo(w.w); v[8 * c + 7] += wg[gI] * bfhi(w.w); } }
        float ss = 0.f;
#pragma unroll
        for (int e = 0; e < 16; ++e) ss += v[e] * v[e];
        ss = wave_sum(ss); const float rstd = rsqrtf(ss * (1.0f / 1024.0f) + EPS);
        bf16_t* op = proj + (size_t)m * NPROJ + PC_Q + lane * 16;
#pragma unroll
        for (int c = 0; c < 2; ++c) { const f32x4 g0 = *(const f32x4*)(gao + lane * 16 + 8 * c), g1 = *(const f32x4*)(gao + lane * 16 + 8 * c + 4);
            u32x4 w; w.x = pk2(v[8 * c] * rstd * g0[0], v[8 * c + 1] * rstd * g0[1]); w.y = pk2(v[8 * c + 2] * rstd * g0[2], v[8 * c + 3] * rstd * g0[3]);
            w.z = pk2(v[8 * c + 4] * rstd * g1[0], v[8 * c + 5] * rstd * g1[1]); w.w = pk2(v[8 * c + 6] * rstd * g1[2], v[8 * c + 7] * rstd * g1[3]);
            *(u32x4*)(op + 8 * c) = w; }
    }
}

__device__ __forceinline__ void p5_kvprep(const Args& a) {
    const int tid = threadIdx.x, lane = tid & 63, wid = tid >> 6;
    const float* kvp = (const float*)(a.ws + WS_KVPART); const float* rstdm = (const float*)(a.ws + WS_RSTDM);
    bf16_t* kc = (bf16_t*)(a.ws + WS_KC); bf16_t* vct = (bf16_t*)(a.ws + WS_VCT); const float* gck = a.in[20];
    const int gw = blockIdx.x * 8 + wid, NGW = gridDim.x * 8;
    for (int it = gw; it < MMEM * 4; it += NGW) {
        const int mm = it >> 2, h = it & 3, b = mm >> 8, j = mm & 255; const float rs = rstdm[mm];
        float k0 = 0.f, k1 = 0.f, v0 = 0.f, v1 = 0.f;
#pragma unroll
        for (int ks = 0; ks < 2; ++ks) { const float* p = kvp + ((size_t)ks * MMEM + mm) * 1024 + h * 128 + 2 * lane;
            const f32x2 kk = *(const f32x2*)p, vv = *(const f32x2*)(p + 512); k0 += kk[0]; k1 += kk[1]; v0 += vv[0]; v1 += vv[1]; }
        k0 *= rs; k1 *= rs; v0 *= rs; v1 *= rs;
        const float ss = wave_sum(k0 * k0 + k1 * k1); const float r = rsqrtf(ss * (1.0f / 128.0f) + EPS);
        *(unsigned*)(kc + ((size_t)(b * 4 + h) * 256 + j) * 128 + 2 * lane) = pk2(k0 * r * gck[2 * lane], k1 * r * gck[2 * lane + 1]);
        vct[((size_t)(b * 4 + h) * 128 + 2 * lane) * 256 + j] = (bf16_t)f2bf(v0);
        vct[((size_t)(b * 4 + h) * 128 + 2 * lane + 1) * 256 + j] = (bf16_t)f2bf(v1);
    }
}

constexpr int KROW = 272, VTROW = 528, LX_K = 0, LX_V = 256 * KROW;
__device__ __forceinline__ void p6_cross(const Args& a, LAS unsigned char* lds) {
    const int tid = threadIdx.x, lane = tid & 63, wid = tid >> 6, l31 = lane & 31, hi = lane >> 5;
    const bf16_t* qp = (const bf16_t*)(a.ws + WS_QPART); const float* sumsq1 = (const float*)(a.ws + WS_SUMSQ1);
    const bf16_t* kc = (const bf16_t*)(a.ws + WS_KC); const bf16_t* vct = (const bf16_t*)(a.ws + WS_VCT); bf16_t* co = (bf16_t*)(a.ws + WS_CO);
    const float* gcq = a.in[19];
    for (int u = blockIdx.x; u < 128; u += gridDim.x) {
        const int qb8 = u & 7, h = (u >> 3) & 3, b = u >> 5; const size_t mq = (size_t)b * SEQ + 256 * qb8 + 32 * wid + l31;
        __syncthreads();
        { const bf16_t* kbase = kc + (size_t)(b * 4 + h) * 256 * 128; const bf16_t* vbase = vct + (size_t)(b * 4 + h) * 128 * 256;
#pragma unroll
          for (int i = 0; i < 8; ++i) { const int ch = tid + 512 * i; const int row = ch >> 4, c16 = ch & 15; *(LAS u32x4*)(lds + LX_K + row * KROW + c16 * 16) = *(const u32x4*)(kbase + row * 128 + c16 * 8); }
#pragma unroll
          for (int i = 0; i < 8; ++i) { const int ch = tid + 512 * i; const int row = ch >> 5, c16 = ch & 31; *(LAS u32x4*)(lds + LX_V + row * VTROW + c16 * 16) = *(const u32x4*)(vbase + row * 256 + c16 * 8); } }
        const float rs1 = rsqrtf(sumsq1[mq] * (1.0f / DM) + EPS);
        bf16x8 qf[8];
        { float qv[8][8]; float ss = 0.f;
#pragma unroll
          for (int kk = 0; kk < 8; ++kk) {
#pragma unroll
              for (int j = 0; j < 8; ++j) qv[kk][j] = 0.f;
#pragma unroll
              for (int ks = 0; ks < 4; ++ks) { const u32x4 w = *(const u32x4*)(qp + ((size_t)ks * MTOK + mq) * DCROSS + h * 128 + 16 * kk + 8 * hi);
                  qv[kk][0] += bflo(w.x); qv[kk][1] += bfhi(w.x); qv[kk][2] += bflo(w.y); qv[kk][3] += bfhi(w.y); qv[kk][4] += bflo(w.z); qv[kk][5] += bfhi(w.z); qv[kk][6] += bflo(w.w); qv[kk][7] += bfhi(w.w); }
#pragma unroll
              for (int j = 0; j < 8; ++j) { qv[kk][j] *= rs1; ss += qv[kk][j] * qv[kk][j]; } }
          ss += __shfl_xor(ss, 32);
          const float r = rsqrtf(ss * (1.0f / 128.0f) + EPS) * 0.08838834764831845f;
#pragma unroll
          for (int kk = 0; kk < 8; ++kk) { const f32x4 g0 = *(const f32x4*)(gcq + 16 * kk + 8 * hi), g1 = *(const f32x4*)(gcq + 16 * kk + 8 * hi + 4);
              qf[kk] = pack8(qv[kk][0] * r * g0[0], qv[kk][1] * r * g0[1], qv[kk][2] * r * g0[2], qv[kk][3] * r * g0[3], qv[kk][4] * r * g1[0], qv[kk][5] * r * g1[1], qv[kk][6] * r * g1[2], qv[kk][7] * r * g1[3]); }
        }
        __syncthreads();
        float m_run = -INFINITY, l_run = 0.f; f32x16 acc[4];
#pragma unroll
        for (int db = 0; db < 4; ++db) acc[db] = zero16();
        for (int kt = 0; kt < 8; ++kt) {
            f32x16 st = zero16();
#pragma unroll
            for (int kk = 0; kk < 8; ++kk) { const bf16x8 kf = *(const LAS bf16x8*)(lds + LX_K + (32 * kt + l31) * KROW + (16 * kk + 8 * hi) * 2); st = MFMA32(kf, qf[kk], st); }
            float mx = -INFINITY;
#pragma unroll
            for (int rr = 0; rr < 16; ++rr) mx = fmaxf(mx, st[rr]);
            mx = fmaxf(mx, __shfl_xor(mx, 32));
            const float m_new = fmaxf(m_run, mx), alpha = __expf(m_run - m_new); float psum = 0.f;
#pragma unroll
            for (int rr = 0; rr < 16; ++rr) { st[rr] = __expf(st[rr] - m_new); psum += st[rr]; }
            psum += __shfl_xor(psum, 32);
            l_run = l_run * alpha + psum; m_run = m_new;
            const bf16x8 p0 = pack8(st[0], st[1], st[2], st[3], st[4], st[5], st[6], st[7]);
            const bf16x8 p1 = pack8(st[8], st[9], st[10], st[11], st[12], st[13], st[14], st[15]);
#pragma unroll
            for (int db = 0; db < 4; ++db) {
#pragma unroll
                for (int rr = 0; rr < 16; ++rr) acc[db][rr] *= alpha;
                const LAS unsigned char* vrow = lds + LX_V + (32 * db + l31) * VTROW + (32 * kt + 4 * hi) * 2;
                { const s16x4 lo = *(const LAS s16x4*)(vrow), h4 = *(const LAS s16x4*)(vrow + 16);
                  bf16x8 af; af[0] = lo[0]; af[1] = lo[1]; af[2] = lo[2]; af[3] = lo[3]; af[4] = h4[0]; af[5] = h4[1]; af[6] = h4[2]; af[7] = h4[3];
                  acc[db] = MFMA32(af, p0, acc[db]); }
                { const s16x4 lo = *(const LAS s16x4*)(vrow + 32), h4 = *(const LAS s16x4*)(vrow + 48);
                  bf16x8 af; af[0] = lo[0]; af[1] = lo[1]; af[2] = lo[2]; af[3] = lo[3]; af[4] = h4[0]; af[5] = h4[1]; af[6] = h4[2]; af[7] = h4[3];
                  acc[db] = MFMA32(af, p1, acc[db]); }
            }
        }
        const float inv = 1.0f / l_run;
        bf16_t* op = co + mq * DCROSS + h * 128 + 4 * hi;
#pragma unroll
        for (int db = 0; db < 4; ++db)
#pragma unroll
            for (int rg = 0; rg < 4; ++rg) { u32x2 w; w.x = pk2(acc[db][4 * rg] * inv, acc[db][4 * rg + 1] * inv); w.y = pk2(acc[db][4 * rg + 2] * inv, acc[db][4 * rg + 3] * inv);
                *(u32x2*)(op + 32 * db + 8 * rg) = w; }
    }
}

#define XB_TMO      128
#define XB_XCNT(j)  (256  + 64 * (j))
#define XB_XSUB(j)  (1280 + 64 * (j))
#define XB_XGEN(j)  (2304 + 64 * (j))
#define XB_TOP      3328
#define XB_TOPGEN   3392
#define XCD_BAR_WORDS 3456
#define XB_SPIN_CAP (1u << 18)
__device__ __forceinline__ unsigned xb_ld(unsigned* p)              { return __hip_atomic_load(p, __ATOMIC_RELAXED, __HIP_MEMORY_SCOPE_AGENT); }
__device__ __forceinline__ unsigned xb_add(unsigned* p, unsigned v) { return __hip_atomic_fetch_add(p, v, __ATOMIC_RELAXED, __HIP_MEMORY_SCOPE_AGENT); }
__device__ __forceinline__ unsigned xb_xcc_id() { return (unsigned)__builtin_amdgcn_s_getreg((3 << 11) | 20) & 0xFu; }
#define XB_SPIN(cond, bar) do { unsigned _sp = 0; while (cond) { __builtin_amdgcn_s_sleep(1); \
    if ((++_sp & 255u) == 0u) { if (xb_ld(&(bar)[XB_TMO])) break; if (_sp > XB_SPIN_CAP) { atomicAdd(&(bar)[XB_TMO], 1u); break; } } } } while (0)
struct XcdBarrier { unsigned* bar; unsigned x; volatile LAS unsigned* st; };
__device__ __forceinline__ XcdBarrier xcd_barrier_post(unsigned* bar, volatile LAS unsigned* st) {
    XcdBarrier b; b.bar = bar; b.x = xb_xcc_id(); b.st = st;
    if (threadIdx.x == 0) (void)xb_add(&bar[XB_XCNT(b.x)], 1u);
    return b;
}
__device__ __forceinline__ void xcd_barrier_complete(unsigned* bar, unsigned x, unsigned& nloc, unsigned& nx) {
    const unsigned G = gridDim.x * gridDim.y * gridDim.z;
    unsigned sum, cnt, mine, sp = 0u;
    for (;;) {
        sum = 0u; cnt = 0u; mine = 0u;
#pragma unroll
        for (unsigned j = 0; j < 16; ++j) { const unsigned c = xb_ld(&bar[XB_XCNT(j)]); sum += c; cnt += (c > 0u) ? 1u : 0u; mine = (j == x) ? c : mine; }
        if (sum == G) break;
        __builtin_amdgcn_s_sleep(1);
        if ((++sp & 255u) == 0u) { if (xb_ld(&bar[XB_TMO])) break; if (sp > XB_SPIN_CAP) { atomicAdd(&bar[XB_TMO], 1u); break; } }
    }
    nloc = mine > 0u ? mine : 1u; nx = cnt > 0u ? cnt : 1u;
}
__device__ __forceinline__ void xcd_barrier(const XcdBarrier& b) {
    asm volatile("s_waitcnt vmcnt(0)" ::: "memory");
    __syncthreads();
    if (threadIdx.x == 0) {
        unsigned* bar = b.bar;
        __builtin_amdgcn_s_waitcnt(0);
        unsigned nloc = b.st[0], nx = b.st[1];
        if (nloc == 0u) { xcd_barrier_complete(bar, b.x, nloc, nx); b.st[0] = nloc; b.st[1] = nx; }
        const unsigned old = xb_add(&bar[XB_XSUB(b.x)], 1u);
        const unsigned gen = old / nloc;
        if (old + 1u == (gen + 1u) * nloc) {
            __builtin_amdgcn_fence(__ATOMIC_RELEASE, "agent");
            asm volatile("s_waitcnt vmcnt(0)" ::: "memory");
            const unsigned og = xb_add(&bar[XB_TOP], 1u);
            const unsigned tg = og / nx;
            if (og + 1u == (tg + 1u) * nx) xb_add(&bar[XB_TOPGEN], 1u);
            else XB_SPIN(xb_ld(&bar[XB_TOPGEN]) == tg, bar);
            __builtin_amdgcn_fence(__ATOMIC_ACQUIRE, "agent");
            xb_add(&bar[XB_XGEN(b.x)], 1u);
            asm volatile("s_waitcnt vmcnt(0)" ::: "memory");
        } else {
            XB_SPIN(xb_ld(&bar[XB_XGEN(b.x)]) == gen, bar);
            __builtin_amdgcn_fence(__ATOMIC_ACQUIRE, "agent");
            asm volatile("s_waitcnt vmcnt(0)" ::: "memory");
        }
    }
    __syncthreads();
}

__global__ void __launch_bounds__(512, 2) mega_fwd(Args a) {
    extern __shared__ __attribute__((aligned(16))) unsigned char lds_raw[];
    LAS unsigned char* lds = (LAS unsigned char*)lds_raw;
    unsigned char* ws = a.ws;
    const int G = gridDim.x, cb = blockIdx.x;
    const int lo = a.lo, hi = a.hi;
#define IN(k) (lo <= (k) && (k) < hi)
#if MK_COOP
    volatile LAS unsigned* bst = (volatile LAS unsigned*)(lds + LDS_BYTES - 64);
    if (threadIdx.x < 2) bst[threadIdx.x] = 0u;
    __syncthreads();
    XcdBarrier xbar = xcd_barrier_post((unsigned*)(ws + WS_BAR), bst);
    if (lo < 0) cg::this_grid().sync();
#define SEAM(k) do { if ((k) + 1 < hi) { xcd_barrier(xbar); } } while (0)
#else
#define SEAM(k) do { } while (0)
#endif
    if (IN(0)) { p0_prologue(a, lds); if (PROBE_DUP == 0) { __syncthreads(); p0_prologue(a, lds); } SEAM(0); }
    if (IN(1)) {
        pg8::Gemm g{(const bf16_t*)(ws + WS_XB), (const bf16_t*)(ws + WS_WIN), DM, DM, MTOK / 256, NPROJ / 256, 1, DM, G, cb};
        pg8::EpiScaleBf16<0, 0> E{(bf16_t*)(ws + WS_PROJ), NPROJ, (const float*)(ws + WS_RSTD0)};
        pg8::gemm_phase(lds, g, E); if (PROBE_DUP == 1) pg8::gemm_phase(lds, g, E); SEAM(1);
    }
    if (IN(2)) { p2_ssd_states(a, lds); if (PROBE_DUP == 2) p2_ssd_states(a, lds); p2_qkprep(a); SEAM(2); }
    if (IN(3)) {
        { pg8::Gemm g{(const bf16_t*)(ws + WS_MEMB), (const bf16_t*)(ws + WS_WCKV), DM, DM, MMEM / 256, (2 * DCROSS) / 256, 2, DM / 2, G, cb};
          pg8::EpiPart E{(float*)(ws + WS_KVPART), 2 * DCROSS, (size_t)MMEM * 2 * DCROSS};
          pg8::gemm_phase(lds, g, E); }
        p3_scan(a); p3_attn(a, lds); SEAM(3);
    }
    if (IN(4)) { p3_ssd_out(a, lds); p4_combine(a); SEAM(4); }
    if (IN(5)) {
        pg8::Gemm g{(const bf16_t*)(ws + WS_PROJ), (const bf16_t*)(ws + WS_WOUT), NPROJ, DM, MTOK / 256, DM / 256, 1, DM, G, cb};
        pg8::EpiResid<0> E{a.in[0], nullptr, nullptr, (bf16_t*)(ws + WS_X1B), (float*)(ws + WS_SUMSQ1)};
        pg8::gemm_phase(lds, g, E); SEAM(5);
    }
    if (IN(6)) {
        pg8::Gemm g{(const bf16_t*)(ws + WS_X1B), (const bf16_t*)(ws + WS_WCQ), DM, DM, MTOK / 256, DCROSS / 256, 4, DM / 4, G, cb};
        pg8::EpiPartBf16 E{(bf16_t*)(ws + WS_QPART), DCROSS, (size_t)MTOK * DCROSS};
        pg8::gemm_phase(lds, g, E);
        p5_kvprep(a); SEAM(6);
    }
    if (IN(7)) {
        p6_cross(a, lds);
        {
            const int wv = threadIdx.x >> 6, ln = threadIdx.x & 63; LAS float* scr = (LAS float*)(lds + wv * 16640);
            __syncthreads();
            int i0, i1, w0, nw;
            if (G == 256) { if (blockIdx.x >= 128) { i0 = 0; i1 = 3200; w0 = (blockIdx.x - 128) * 8 + wv; } else { i0 = 3200; i1 = 4096; w0 = blockIdx.x * 8 + wv; } nw = 1024; }
            else { i0 = 0; i1 = 4096; w0 = blockIdx.x * 8 + wv; nw = G * 8; }
            for (int it = i0 + w0; it < i1; it += nw) { int r = it; p0_mat(r, a.in[24], DFF, DM, DM, (bf16_t*)(ws + WS_WDOWN), nullptr, false, scr, ln); }
        }
        SEAM(7);
    }
    if (IN(8)) {
        pg8::Gemm g{(const bf16_t*)(ws + WS_CO), (const bf16_t*)(ws + WS_WCO), DCROSS, DCROSS, MTOK / 256, DM / 256, 1, DCROSS, G, cb};
        pg8::EpiResid<1> E{nullptr, (const bf16_t*)(ws + WS_X1B), nullptr, (bf16_t*)(ws + WS_X2B), (float*)(ws + WS_SUMSQ2)};
        pg8::gemm_phase(lds, g, E); SEAM(8);
    }
    if (IN(9)) {
        pg8::Gemm g{(const bf16_t*)(ws + WS_X2B), (const bf16_t*)(ws + WS_WUP), DM, DM, MTOK / 256, DFF / 256, 1, DM, G, cb};
        pg8::EpiScaleBf16<1, 1> E{(bf16_t*)(ws + WS_HID), DFF, (const float*)(ws + WS_SUMSQ2)};
        pg8::gemm_phase(lds, g, E); if (PROBE_DUP == 9) pg8::gemm_phase(lds, g, E); SEAM(9);
    }
    if (IN(10)) {
        pg8::Gemm g{(const bf16_t*)(ws + WS_HID), (const bf16_t*)(ws + WS_WDOWN), DFF, DFF, MTOK / 256, DM / 256, 1, DFF, G, cb};
        pg8::EpiResid<2> E{nullptr, (const bf16_t*)(ws + WS_X2B), a.out, nullptr, nullptr};
        pg8::gemm_phase(lds, g, E);
    }
#undef IN
#undef SEAM
}

extern "C" void kernel_launch(void* const* d_in, const int* in_sizes, int n_in, void* d_out, int out_size, void* d_ws, size_t ws_size, hipStream_t stream) {
    static int grid = 0;
    if (grid == 0) {
        if (n_in != 25 || out_size != MTOK * DM || ws_size < WS_END) { fprintf(stderr, "kernel_launch: unexpected problem (n_in %d, out %d, ws %zu < %zu)\n", n_in, out_size, ws_size, (size_t)WS_END); grid = -1; return; }
        int dev = 0, cus = 0, per_cu = 0;
        hipGetDevice(&dev); hipDeviceGetAttribute(&cus, hipDeviceAttributeMultiprocessorCount, dev);
        if (hipFuncSetAttribute((const void*)mega_fwd, hipFuncAttributeMaxDynamicSharedMemorySize, LDS_BYTES) != hipSuccess) { fprintf(stderr, "kernel_launch: hipFuncSetAttribute failed\n"); grid = -1; return; }
        if (hipOccupancyMaxActiveBlocksPerMultiprocessor(&per_cu, (const void*)mega_fwd, 512, LDS_BYTES) != hipSuccess || per_cu < 1) { fprintf(stderr, "kernel_launch: occupancy query says %d\n", per_cu); per_cu = 1; }
        (void)hipGetLastError();
        grid = cus;
    }
    if (grid < 0) return;
    Args a{};
    for (int i = 0; i < 25; ++i) a.in[i] = (const float*)d_in[i];
    a.out = (float*)d_out; a.ws = (unsigned char*)d_ws;
#if MK_COOP
    a.lo = 0; a.hi = NPHASE;
    if (hipMemsetAsync((char*)d_ws + WS_BAR, 0, BAR_BYTES, stream) != hipSuccess) { fprintf(stderr, "kernel_launch: memset of the barrier words failed\n"); return; }
    void* args[] = {&a};
    hipError_t e = hipLaunchCooperativeKernel((const void*)mega_fwd, dim3(grid), dim3(512), args, LDS_BYTES, stream);
    if (e != hipSuccess) fprintf(stderr, "cooperative launch failed: %s (grid %d)\n", hipGetErrorString(e), grid);
#else
    for (int ph = 0; ph < NPHASE; ++ph) {
        a.lo = ph; a.hi = ph + 1;
        hipLaunchKernelGGL(mega_fwd, dim3(grid), dim3(512), LDS_BYTES, stream, a);
    }
#endif
}
```
